# Optimizing an MI355X kernel written in HIP

```python
import jax, jax.numpy as jnp
from jax import lax
import numpy as np

D_MODEL = 1024
BATCH = 8
SEQ = 4096
DEPTH = 1
DEC_BATCH = 32
DEC_SEQ = 2048
PAST_LEN = 128

MIX_WIDTH = D_MODEL
A_WIDTH = MIX_WIDTH // 2
A_HEADS = 4
A_HEAD_DIM = A_WIDTH // A_HEADS
CHUNK = 128
B_HEADS = 4
NOPE_DIM = 128
ROPE_DIM = 64
V_DIM = 128
QK_DIM = NOPE_DIM + ROPE_DIM
B_WIDTH = B_HEADS * V_DIM
Q_RANK = 384
KV_RANK = 256
IN_COLS = 2 * A_WIDTH + Q_RANK + KV_RANK + ROPE_DIM
D_FF = 4 * D_MODEL
Q_BLOCK = 128
ROPE_BASE = 10000.0
EPS = 1e-6
ATTN_SCALE = QK_DIM ** -0.5

kernel_name = "hymba_gmlp_mla_encoder"


def rms_norm(x, g):
    xf = x.astype(jnp.float32)
    y = xf * lax.rsqrt(jnp.mean(xf * xf, axis=-1, keepdims=True) + EPS)
    return (y * g.astype(jnp.float32)).astype(x.dtype)


def rope_tables(seq):
    inv = 1.0 / (ROPE_BASE ** (jnp.arange(0, ROPE_DIM, 2, dtype=jnp.float32) / ROPE_DIM))
    ang = jnp.arange(seq, dtype=jnp.float32)[:, None] * inv[None, :]
    return jnp.cos(ang), jnp.sin(ang)


def apply_rope(x, cos, sin):
    x1, x2 = jnp.split(x.astype(jnp.float32), 2, axis=-1)
    c = cos[None, :, None, :]
    s = sin[None, :, None, :]
    return jnp.concatenate([x1 * c - x2 * s, x1 * s + x2 * c], axis=-1).astype(x.dtype)


def chunked_spatial_gating(u, v, sgu_norm, w_spatial, b_spatial):
    bsz, seq, _ = u.shape
    n_chunks = seq // CHUNK
    v = rms_norm(v.reshape(bsz, seq, A_HEADS, A_HEAD_DIM), sgu_norm.reshape(A_HEADS, A_HEAD_DIM))
    v = v.reshape(bsz, n_chunks, CHUNK, A_HEADS, A_HEAD_DIM)
    s = jnp.einsum('hpq,bcqhd->bcphd', w_spatial, v) + b_spatial.T[None, None, :, :, None]
    return u * s.reshape(bsz, seq, A_WIDTH)


def latent_attention(c_q, c_kv, k_rope, q_norm, w_uq, kv_norm, w_ukv, cos, sin):
    bsz, seq, _ = c_q.shape
    q = jnp.einsum('bsr,rn->bsn', rms_norm(c_q, q_norm), w_uq).reshape(bsz, seq, B_HEADS, QK_DIM)
    kv = jnp.einsum('bsr,rn->bsn', rms_norm(c_kv, kv_norm), w_ukv).reshape(bsz, seq, B_HEADS, NOPE_DIM + V_DIM)
    q_nope, q_pe = q[..., :NOPE_DIM], q[..., NOPE_DIM:]
    k_nope, v = kv[..., :NOPE_DIM], kv[..., NOPE_DIM:]
    q_pe = apply_rope(q_pe, cos, sin)
    k_pe = apply_rope(k_rope[:, :, None, :], cos, sin)
    q = jnp.concatenate([q_nope, q_pe], axis=-1) * ATTN_SCALE
    k = jnp.concatenate([k_nope, jnp.broadcast_to(k_pe, (bsz, seq, B_HEADS, ROPE_DIM))], axis=-1)
    q_blocks = q.reshape(bsz, seq // Q_BLOCK, Q_BLOCK, B_HEADS, QK_DIM).transpose(1, 0, 2, 3, 4)

    def attend(qb):
        sc = jnp.einsum('bqhd,bkhd->bhqk', qb, k).astype(jnp.float32)
        p = jax.nn.softmax(sc, axis=-1).astype(v.dtype)
        return jnp.einsum('bhqk,bkhd->bqhd', p, v)

    o = lax.map(attend, q_blocks)
    return o.transpose(1, 0, 2, 3, 4).reshape(bsz, seq, B_WIDTH)


def encoder_layer(x, norm_mix, w_in, sgu_norm, w_spatial, b_spatial, q_norm, w_uq, kv_norm, w_ukv,
                  out_norm_a, out_norm_b, w_out, norm_ffn, w_ff1, w_ff2, cos, sin):
    h = rms_norm(x, norm_mix)
    z = jnp.einsum('bsd,dn->bsn', h, w_in)
    uv = jax.nn.gelu(z[..., :2 * A_WIDTH])
    u, v = uv[..., :A_WIDTH], uv[..., A_WIDTH:]
    o = 2 * A_WIDTH
    c_q = z[..., o:o + Q_RANK]
    o = o + Q_RANK
    c_kv = z[..., o:o + KV_RANK]
    o = o + KV_RANK
    k_rope = z[..., o:o + ROPE_DIM]
    y_a = chunked_spatial_gating(u, v, sgu_norm, w_spatial, b_spatial)
    y_b = latent_attention(c_q, c_kv, k_rope, q_norm, w_uq, kv_norm, w_ukv, cos, sin)
    y = jnp.concatenate([rms_norm(y_a, out_norm_a), rms_norm(y_b, out_norm_b)], axis=-1)
    x = x + jnp.einsum('bsm,md->bsd', y, w_out)
    h = rms_norm(x, norm_ffn)
    f = jnp.square(jax.nn.relu(jnp.einsum('bsd,df->bsf', h, w_ff1)))
    return x + jnp.einsum('bsf,fd->bsd', f, w_ff2)


def run_trunk(x, norm_mix, w_in, sgu_norm, w_spatial, b_spatial, q_norm, w_uq, kv_norm, w_ukv,
              out_norm_a, out_norm_b, w_out, norm_ffn, w_ff1, w_ff2, norm_final):
    cos, sin = rope_tables(x.shape[1])
    for l in range(DEPTH):
        x = encoder_layer(x, norm_mix[l], w_in[l], sgu_norm[l], w_spatial[l], b_spatial[l],
                          q_norm[l], w_uq[l], kv_norm[l], w_ukv[l], out_norm_a[l], out_norm_b[l],
                          w_out[l], norm_ffn[l], w_ff1[l], w_ff2[l], cos, sin)
    return rms_norm(x, norm_final)


def setup_inputs(seed: int = 0) -> dict:
    key = jax.random.key(seed)
    ks = jax.random.split(key, 20)
    f32 = jnp.float32

    def nrm(k, shape, scale):
        return jax.random.normal(k, shape, dtype=f32) * scale

    def gain(k, shape):
        return 1.0 + 0.02 * jax.random.normal(k, shape, dtype=f32)

    L = DEPTH
    return {
        "x_prompt": jax.random.normal(ks[0], (BATCH, SEQ, D_MODEL), dtype=f32),
        "x_sample": jax.random.normal(ks[1], (DEC_BATCH, DEC_SEQ, D_MODEL), dtype=f32),
        "norm_mix": gain(ks[2], (L, D_MODEL)),
        "w_in": nrm(ks[3], (L, D_MODEL, IN_COLS), D_MODEL ** -0.5),
        "sgu_norm": gain(ks[4], (L, A_WIDTH)),
        "w_spatial": nrm(ks[5], (L, A_HEADS, CHUNK, CHUNK), CHUNK ** -0.5),
        "b_spatial": 1.0 + 0.1 * jax.random.normal(ks[6], (L, A_HEADS, CHUNK), dtype=f32),
        "q_norm": gain(ks[7], (L, Q_RANK)),
        "w_uq": nrm(ks[8], (L, Q_RANK, B_HEADS * QK_DIM), Q_RANK ** -0.5),
        "kv_norm": gain(ks[9], (L, KV_RANK)),
        "w_ukv": nrm(ks[10], (L, KV_RANK, B_HEADS * (NOPE_DIM + V_DIM)), KV_RANK ** -0.5),
        "out_norm_a": gain(ks[11], (L, A_WIDTH)),
        "out_norm_b": gain(ks[12], (L, B_WIDTH)),
        "w_out": nrm(ks[13], (L, MIX_WIDTH, D_MODEL), MIX_WIDTH ** -0.5),
        "norm_ffn": gain(ks[14], (L, D_MODEL)),
        "w_ff1": nrm(ks[15], (L, D_MODEL, D_FF), D_MODEL ** -0.5),
        "w_ff2": nrm(ks[16], (L, D_FF, D_MODEL), D_FF ** -0.5),
        "norm_final": gain(ks[17], (D_MODEL,)),
    }


def reference(x_prompt, x_sample, norm_mix, w_in, sgu_norm, w_spatial, b_spatial, q_norm, w_uq,
              kv_norm, w_ukv, out_norm_a, out_norm_b, w_out, norm_ffn, w_ff1, w_ff2, norm_final):
    y_prompt = run_trunk(x_prompt, norm_mix, w_in, sgu_norm, w_spatial, b_spatial, q_norm, w_uq,
                         kv_norm, w_ukv, out_norm_a, out_norm_b, w_out, norm_ffn, w_ff1, w_ff2, norm_final)
    y_sample = run_trunk(x_sample, norm_mix, w_in, sgu_norm, w_spatial, b_spatial, q_norm, w_uq,
                         kv_norm, w_ukv, out_norm_a, out_norm_b, w_out, norm_ffn, w_ff1, w_ff2, norm_final)
    return (y_prompt, y_sample)
```

```cpp
#include <hip/hip_runtime.h>
#include <hip/hip_cooperative_groups.h>
#include <cstdio>
#include <cstdint>
namespace pg8 {
#define PG8_LAS __attribute__((address_space(3)))
typedef unsigned short bf16_t;
typedef short bf16x8 __attribute__((ext_vector_type(8)));
typedef float f32x4 __attribute__((ext_vector_type(4)));
typedef unsigned u32x4 __attribute__((ext_vector_type(4)));
constexpr int BM = 256, BK = 64, HALF = 128, HTB = HALF * BK * 2  , STAGE_BYTES = 8 * HTB, NXCD = 8, WGM = 8;

__host__ __device__ __forceinline__ int lds_byte(int r, int c) { const int st = (r >> 4) * 2 + (c >> 5), rr = r & 15, cc = c & 31, ob = rr * 64 + cc * 2; return st * 1024 + (ob ^ (((ob >> 9) & 1) << 5)); }
__host__ __device__ __forceinline__ void stage_rc(int b, int& R, int& C) { const int st = b / 1024, sb = b % 1024, swz = sb ^ (((sb >> 9) & 1) << 5); R = (st >> 1) * 16 + swz / 64; C = (st & 1) * 32 + (swz % 64) / 2; }
__host__ __device__ __forceinline__ int perm32(int rho) { const int n = rho >> 4, i = rho & 15; return 8 * (i >> 2) + 4 * n + (i & 3); }

struct Unit { int pm, pn; };
struct Gemm { const bf16_t* A; const bf16_t* Bt; int M, N, K, lda, ldb; };

struct StaticOrder {
    int nM, nN, nwg, G, c;
    __host__ __device__ void init(int M, int N, int G_, int c_) { nM = M / BM; nN = N / BM; nwg = nM * nN; G = G_; c = c_; }
    __host__ __device__ bool next(int i, Unit& u) const {
        const long L = (long)i * G + c; if (L >= nwg) return false;
        int wgid = (int)L; { const int q = nwg / NXCD, r = nwg % NXCD, xcd = wgid % NXCD, off = wgid / NXCD; wgid = (xcd < r ? xcd * (q + 1) : r * (q + 1) + (xcd - r) * q) + off; }
        const int nig = WGM * nN, gid = wgid / nig, fm = gid * WGM, gsz = (nM - fm) < WGM ? (nM - fm) : WGM;
        u.pm = fm + ((wgid % nig) % gsz); u.pn = (wgid % nig) / gsz; return true;
    }
    __device__ __forceinline__ void a_ready(const Unit&) const {}
    __device__ __forceinline__ void done(const Unit&) const {}
};


__device__ __forceinline__ unsigned cvt_pk_bf16(float lo, float hi) { unsigned r; asm volatile("v_cvt_pk_bf16_f32 %0, %1, %2" : "=v"(r) : "v"(lo), "v"(hi)); return r; }
__device__ __forceinline__ u32x4 pack8(const f32x4 v0, const f32x4 v1) { u32x4 w; w.x = cvt_pk_bf16(v0[0], v0[1]); w.y = cvt_pk_bf16(v0[2], v0[3]); w.z = cvt_pk_bf16(v1[0], v1[1]); w.w = cvt_pk_bf16(v1[2], v1[3]); return w; }
__device__ __forceinline__ float gelu_tanh(float x) {
    const float t = x * (1.0f + 0.044715f * x * x) * (-2.0f * 0.7978845608028654f * 1.4426950408889634f);
    return x * __builtin_amdgcn_rcpf(1.0f + __builtin_amdgcn_exp2f(t));
}
__device__ __forceinline__ f32x4 gelu4(f32x4 v) { return (f32x4){gelu_tanh(v[0]), gelu_tanh(v[1]), gelu_tanh(v[2]), gelu_tanh(v[3])}; }
__device__ __forceinline__ float sumsq8(const f32x4 a, const f32x4 b) { return (a[0] * a[0] + a[1] * a[1]) + (a[2] * a[2] + a[3] * a[3]) + (b[0] * b[0] + b[1] * b[1]) + (b[2] * b[2] + b[3] * b[3]); }
__device__ __forceinline__ float sum4(const f32x4 a) { return (a[0] + a[1]) + (a[2] + a[3]); }
__device__ __forceinline__ float fq_sum(float s) { s += __shfl_xor(s, 16); s += __shfl_xor(s, 32); return s; }
__device__ __forceinline__ int row_pos(int row) { return row < 32768 ? (row & 4095) : (row & 2047); }
__device__ __forceinline__ void rope8(f32x4& v0, f32x4& v1, const float* ropec, const float* ropes, int pos, int i0) {
    const f32x4 c = *(const f32x4*)(ropec + pos * 32 + i0), s = *(const f32x4*)(ropes + pos * 32 + i0);
    const f32x4 a = v0, b = v1;
    v0[0] = a[0] * c[0] - a[1] * s[0]; v0[1] = a[0] * s[0] + a[1] * c[0];
    v0[2] = a[2] * c[1] - a[3] * s[1]; v0[3] = a[2] * s[1] + a[3] * c[1];
    v1[0] = b[0] * c[2] - b[1] * s[2]; v1[1] = b[0] * s[2] + b[1] * c[2];
    v1[2] = b[2] * c[3] - b[3] * s[3]; v1[3] = b[2] * s[3] + b[3] * c[3];
}

struct EpiZ {
    static constexpr bool PERM = true, AFTER_DRAIN = false;
    bf16_t* Z; bf16_t* KF; float* stat1; const float* ropec; const float* ropes;
    __device__ __forceinline__ void operator()(const f32x4 (&acc)[2][2][4][2], const Unit& u, int wr, int wc, int fr, int fq) const {
        asm volatile("" : "+v"(fr), "+v"(fq));
        const int row0 = u.pm * BM + wr * 64 + fr;
#pragma unroll
        for (int ai = 0; ai < 2; ++ai)
#pragma unroll
            for (int m = 0; m < 4; ++m) { const int row = row0 + ai * HALF + m * 16;
#pragma unroll
                for (int bj = 0; bj < 2; ++bj) { const int hidx = 2 * u.pn + bj; const int col8 = u.pn * BM + bj * HALF + wc * 32 + 8 * fq;
                    f32x4 v0 = acc[ai][bj][m][0], v1 = acc[ai][bj][m][1];
                    if (u.pn < 4) { v0 = gelu4(v0); v1 = gelu4(v1); *(u32x4*)(Z + (size_t)row * 1792 + col8) = pack8(v0, v1); }
                    else if (hidx <= 12) { *(u32x4*)(Z + (size_t)row * 1792 + col8) = pack8(v0, v1);
                        const float ss = fq_sum(sumsq8(v0, v1)); if (fq == 0) stat1[(size_t)row * 20 + (hidx - 8) * 4 + wc] = ss; }
                    else if (wc < 2) { rope8(v0, v1, ropec, ropes, row_pos(row), 16 * wc + 4 * fq); const u32x4 w = pack8(v0, v1);
                        bf16_t* kp = KF + (size_t)row * 768 + 128 + 32 * wc + 8 * fq;
#pragma unroll
                        for (int h = 0; h < 4; ++h) *(u32x4*)(kp + h * 192) = w; }
                } }
    }
};
struct EpiQ {
    static constexpr bool PERM = true, AFTER_DRAIN = false;
    bf16_t* Q; const float* stat1; const float* ropec; const float* ropes;
    __device__ __forceinline__ void operator()(const f32x4 (&acc)[2][2][4][2], const Unit& u, int wr, int wc, int fr, int fq) const {
        asm volatile("" : "+v"(fr), "+v"(fq));
        const int row0 = u.pm * BM + wr * 64 + fr; const float QS = 0.07216878364870322f * 1.4426950408889634f;
#pragma unroll
        for (int ai = 0; ai < 2; ++ai)
#pragma unroll
            for (int m = 0; m < 4; ++m) { const int row = row0 + ai * HALF + m * 16;
                float part = 0.f; if (fq < 3) part = sum4(*(const f32x4*)(stat1 + (size_t)row * 20 + 4 * fq));
                part = fq_sum(part); const float rs = __builtin_amdgcn_rsqf(part * (1.0f / 384.0f) + 1e-6f) * QS; const int pos = row_pos(row);
#pragma unroll
                for (int bj = 0; bj < 2; ++bj) { const int col8 = u.pn * BM + bj * HALF + wc * 32 + 8 * fq; const int d = col8 % 192;
                    f32x4 v0 = acc[ai][bj][m][0] * rs, v1 = acc[ai][bj][m][1] * rs;
                    { const bool pe = d >= 128; const int i0 = pe ? (d - 128) >> 1 : 0; f32x4 c = *(const f32x4*)(ropec + pos * 32 + i0), s = *(const f32x4*)(ropes + pos * 32 + i0);
                      if (!pe) { c = (f32x4){1.f, 1.f, 1.f, 1.f}; s = (f32x4){0.f, 0.f, 0.f, 0.f}; }
                      const f32x4 a = v0, b = v1;
                      v0[0] = a[0] * c[0] - a[1] * s[0]; v0[1] = a[0] * s[0] + a[1] * c[0]; v0[2] = a[2] * c[1] - a[3] * s[1]; v0[3] = a[2] * s[1] + a[3] * c[1];
                      v1[0] = b[0] * c[2] - b[1] * s[2]; v1[1] = b[0] * s[2] + b[1] * c[2]; v1[2] = b[2] * c[3] - b[3] * s[3]; v1[3] = b[2] * s[3] + b[3] * c[3]; }
                    *(u32x4*)(Q + (size_t)row * 768 + col8) = pack8(v0, v1); } }
    }
};
struct EpiKV {
    static constexpr bool PERM = true, AFTER_DRAIN = false;
    bf16_t* KF; bf16_t* VF; const float* stat1;
    __device__ __forceinline__ void operator()(const f32x4 (&acc)[2][2][4][2], const Unit& u, int wr, int wc, int fr, int fq) const {
        asm volatile("" : "+v"(fr), "+v"(fq));
        const int row0 = u.pm * BM + wr * 64 + fr;
#pragma unroll
        for (int ai = 0; ai < 2; ++ai)
#pragma unroll
            for (int m = 0; m < 4; ++m) { const int row = row0 + ai * HALF + m * 16;
                float part = 0.f; if (fq < 2) part = sum4(*(const f32x4*)(stat1 + (size_t)row * 20 + 12 + 4 * fq));
                part = fq_sum(part); const float rs = __builtin_amdgcn_rsqf(part * (1.0f / 256.0f) + 1e-6f);
#pragma unroll
                for (int bj = 0; bj < 2; ++bj) { const int cin = wc * 32 + 8 * fq;
                    const f32x4 v0 = acc[ai][bj][m][0] * rs, v1 = acc[ai][bj][m][1] * rs;
                    bf16_t* dst = (u.pn < 2) ? KF + (size_t)row * 768 + (2 * u.pn + bj) * 192 + cin : VF + (size_t)row * 512 + (2 * (u.pn - 2) + bj) * 128 + cin;
                    *(u32x4*)dst = pack8(v0, v1); } }
    }
};
struct EpiX1 {
    static constexpr bool PERM = true, AFTER_DRAIN = false;
    const float* xp; const float* xs; float* X1; bf16_t* XB; float* stat2;
    __device__ __forceinline__ void operator()(const f32x4 (&acc)[2][2][4][2], const Unit& u, int wr, int wc, int fr, int fq) const {
        asm volatile("" : "+v"(fr), "+v"(fq));
        const int row0 = u.pm * BM + wr * 64 + fr;
        const float* xb = (u.pm < 128) ? xp : xs; const size_t xsub = (u.pm < 128) ? 0 : (size_t)32768 * 1024;
#pragma unroll
        for (int ai = 0; ai < 2; ++ai)
#pragma unroll
            for (int m = 0; m < 4; ++m) { const int row = row0 + ai * HALF + m * 16; float ss = 0.f;
#pragma unroll
                for (int bj = 0; bj < 2; ++bj) { const size_t off = (size_t)row * 1024 + u.pn * BM + bj * HALF + wc * 32 + 8 * fq;
                    const f32x4 v0 = acc[ai][bj][m][0] + *(const f32x4*)(xb + (off - xsub)), v1 = acc[ai][bj][m][1] + *(const f32x4*)(xb + (off - xsub) + 4);
                    *(f32x4*)(X1 + off) = v0; *(f32x4*)(X1 + off + 4) = v1; *(u32x4*)(XB + off) = pack8(v0, v1); ss += sumsq8(v0, v1); }
                ss = fq_sum(ss); if (fq == 0) stat2[(size_t)row * 16 + u.pn * 4 + wc] = ss; }
    }
};
struct EpiF {
    static constexpr bool PERM = true, AFTER_DRAIN = false;
    bf16_t* F; const float* stat2;
    __device__ __forceinline__ void operator()(const f32x4 (&acc)[2][2][4][2], const Unit& u, int wr, int wc, int fr, int fq) const {
        asm volatile("" : "+v"(fr), "+v"(fq));
        const int row0 = u.pm * BM + wr * 64 + fr;
#pragma unroll
        for (int ai = 0; ai < 2; ++ai)
#pragma unroll
            for (int m = 0; m < 4; ++m) { const int row = row0 + ai * HALF + m * 16;
                const float part = fq_sum(sum4(*(const f32x4*)(stat2 + (size_t)row * 16 + 4 * fq))); const float rs = __builtin_amdgcn_rsqf(part * (1.0f / 1024.0f) + 1e-6f);
#pragma unroll
                for (int bj = 0; bj < 2; ++bj) { const size_t off = (size_t)row * 4096 + u.pn * BM + bj * HALF + wc * 32 + 8 * fq;
                    f32x4 v0 = acc[ai][bj][m][0] * rs, v1 = acc[ai][bj][m][1] * rs;
#pragma unroll
                    for (int e = 0; e < 4; ++e) { const float a = fmaxf(v0[e], 0.f), b = fmaxf(v1[e], 0.f); v0[e] = a * a; v1[e] = b * b; }
                    *(u32x4*)(F + off) = pack8(v0, v1); } }
    }
};
struct EpiX2 {
    static constexpr bool PERM = true, AFTER_DRAIN = false;
    float* X;
    __device__ __forceinline__ void operator()(const f32x4 (&acc)[2][2][4][2], const Unit& u, int wr, int wc, int fr, int fq) const {
        asm volatile("" : "+v"(fr), "+v"(fq));
        const int row0 = u.pm * BM + wr * 64 + fr;
#pragma unroll
        for (int ai = 0; ai < 2; ++ai)
#pragma unroll
            for (int m = 0; m < 4; ++m) { const int row = row0 + ai * HALF + m * 16;
#pragma unroll
                for (int bj = 0; bj < 2; ++bj) { const size_t off = (size_t)row * 1024 + u.pn * BM + bj * HALF + wc * 32 + 8 * fq;
                    const f32x4 v0 = acc[ai][bj][m][0] + *(const f32x4*)(X + off), v1 = acc[ai][bj][m][1] + *(const f32x4*)(X + off + 4);
                    *(f32x4*)(X + off) = v0; *(f32x4*)(X + off + 4) = v1; } }
    }
};
template <class Epi, class Sched, bool ALIGN_EPI = false, bool SP2 = false>
__device__ __forceinline__ void gemm_phase(PG8_LAS unsigned char* lds, const Gemm g, const Sched& S, const Epi& E) {
    int tid_ = threadIdx.x; asm volatile("" : "+v"(tid_));
    const int tid = tid_, wid = __builtin_amdgcn_readfirstlane(tid >> 6), lane = tid & 63, wr = wid >> 2, wc = wid & 3, fr = lane & 15, fq = lane >> 4;
    const int K = g.K, nt = K / BK;
    unsigned voffA[2], voffB[2];
#pragma unroll
    for (int i = 0; i < 2; ++i) { int R, C; stage_rc(tid * 16 + i * 8192, R, C); const int Rb = Epi::PERM ? ((R & ~31) + perm32(R & 31)) : R;
        voffA[i] = (unsigned)(R * g.lda + C) * 2u; voffB[i] = (unsigned)(Rb * g.ldb + C) * 2u; }
    const size_t kstep = (size_t)(BK * 2);
    const size_t hstepA = (size_t)HALF * g.lda * 2, hstepB = (size_t)HALF * g.ldb * 2;
    const size_t tstepA = 2 * hstepA, tstepB = 2 * hstepB;
    const unsigned ldsw = (unsigned)wid * 1024u;
    const int aoff = lds_byte(wr * 64 + fr, fq * 8), boff = lds_byte(wc * 32 + fr, fq * 8);
#define PG8_SA(b, h) (((b) * 2 + (h)) * HTB)
#define PG8_SB(b, h) ((4 + (b) * 2 + (h)) * HTB)
#define PG8_STAGE(bufoff, gbase, voff) do { _Pragma("unroll") for (int _i = 0; _i < 2; ++_i) \
        __builtin_amdgcn_global_load_lds((const unsigned*)((const char*)(gbase) + (voff)[_i]), (PG8_LAS unsigned*)(lds + (bufoff) + ldsw + _i * 8192), 16, 0, 0); } while (0)
#define PG8_LDA(dst, b, h) do { _Pragma("unroll") for (int m = 0; m < 4; ++m) _Pragma("unroll") for (int k = 0; k < 2; ++k) dst[m][k] = *(const PG8_LAS bf16x8*)(lds + PG8_SA(b, h) + aoff + m * 2048 + k * 1024); } while (0)
#define PG8_LDB(dst, b, h) do { _Pragma("unroll") for (int n = 0; n < 2; ++n) _Pragma("unroll") for (int k = 0; k < 2; ++k) dst[n][k] = *(const PG8_LAS bf16x8*)(lds + PG8_SB(b, h) + boff + n * 2048 + k * 1024); } while (0)
#define PG8_MMA(ai, bj, At, Bt) do { __builtin_amdgcn_s_setprio(1); _Pragma("unroll") for (int m = 0; m < 4; ++m) _Pragma("unroll") for (int n = 0; n < 2; ++n) _Pragma("unroll") for (int k = 0; k < 2; ++k) \
        acc[ai][bj][m][n] = __builtin_amdgcn_mfma_f32_16x16x32_bf16(Bt[n][k], At[m][k], acc[ai][bj][m][n], 0, 0, 0); __builtin_amdgcn_s_setprio(0); } while (0)
#define PG8_WAIT_V(n) asm volatile("s_waitcnt vmcnt(" #n ")" ::: "memory")
#define PG8_WAIT_L(n) asm volatile("s_waitcnt lgkmcnt(" #n ")" ::: "memory")
#define PG8_BAR __builtin_amdgcn_s_barrier()
#define PG8_SCHED __builtin_amdgcn_sched_barrier(0)
    Unit cur, nxt; int ui = 0;
    if (!S.next(0, cur)) return;
    f32x4 acc[2][2][4][2];
#pragma unroll
    for (int a = 0; a < 2; ++a)
#pragma unroll
        for (int b = 0; b < 2; ++b)
#pragma unroll
            for (int m = 0; m < 4; ++m)
#pragma unroll
                for (int n = 0; n < 2; ++n) acc[a][b][m][n] = (f32x4){0.f, 0.f, 0.f, 0.f};
    bf16x8 At[4][2], B0[2][2], B1[2][2];
    const char* cA = (const char*)g.A + (size_t)cur.pm * tstepA; const char* cB = (const char*)g.Bt + (size_t)cur.pn * tstepB;
    S.a_ready(cur);
    if constexpr (SP2) {
        PG8_STAGE(PG8_SB(0, 0), cB, voffB); PG8_STAGE(PG8_SB(0, 1), cB + hstepB, voffB); PG8_STAGE(PG8_SA(0, 0), cA, voffA); PG8_STAGE(PG8_SA(0, 1), cA + hstepA, voffA);
        if (wr == 1) PG8_BAR;
        PG8_WAIT_V(2); PG8_BAR;
        PG8_STAGE(PG8_SB(1, 0), cB + kstep, voffB); PG8_STAGE(PG8_SA(1, 0), cA + kstep, voffA); PG8_STAGE(PG8_SB(1, 1), cB + hstepB + kstep, voffB);
        PG8_WAIT_V(6); PG8_BAR;
    } else {
        PG8_STAGE(PG8_SB(0, 0), cB, voffB); PG8_STAGE(PG8_SA(0, 0), cA, voffA); PG8_STAGE(PG8_SB(0, 1), cB + hstepB, voffB); PG8_STAGE(PG8_SA(0, 1), cA + hstepA, voffA);
        if (wr == 1) PG8_BAR;
        PG8_WAIT_V(4); PG8_BAR;
        PG8_STAGE(PG8_SB(1, 0), cB + kstep, voffB); PG8_STAGE(PG8_SA(1, 0), cA + kstep, voffA); PG8_STAGE(PG8_SB(1, 1), cB + hstepB + kstep, voffB);
        PG8_WAIT_V(6); PG8_BAR;
    }
    for (;;) {
        const bool has_next = S.next(ui + 1, nxt);
        const char* nA = has_next ? (const char*)g.A + (size_t)nxt.pm * tstepA : cA; const char* nB = has_next ? (const char*)g.Bt + (size_t)nxt.pn * tstepB : cB;
#pragma unroll 1
        for (int t = 0; t < nt; t += 2) {
            const bool last = (t == nt - 2);
            const char* a1 = cA + (size_t)(t + 1) * kstep;
            const char* a2 = last ? nA : cA + (size_t)(t + 2) * kstep; const char* b2 = last ? nB : cB + (size_t)(t + 2) * kstep;
            const char* a3 = a2 + kstep; const char* b3 = b2 + kstep;
            if (last && has_next) S.a_ready(nxt);
            if constexpr (SP2) {
            PG8_LDB(B0, 0, 0); PG8_LDB(B1, 0, 1); PG8_SCHED; PG8_LDA(At, 0, 0); PG8_STAGE(PG8_SA(1, 1), a1 + hstepA, voffA);
            PG8_WAIT_V(8); PG8_WAIT_L(0); PG8_BAR; PG8_MMA(0, 0, At, B0); PG8_MMA(0, 1, At, B1); PG8_BAR; PG8_SCHED;
            PG8_LDA(At, 0, 1); PG8_STAGE(PG8_SB(0, 0), b2, voffB); PG8_STAGE(PG8_SB(0, 1), b2 + hstepB, voffB); PG8_STAGE(PG8_SA(0, 0), a2, voffA);
            PG8_WAIT_V(8); PG8_WAIT_L(0); PG8_BAR; PG8_MMA(1, 0, At, B0); PG8_MMA(1, 1, At, B1); PG8_BAR; PG8_SCHED;
            PG8_LDB(B0, 1, 0); PG8_LDB(B1, 1, 1); PG8_SCHED; PG8_LDA(At, 1, 0); PG8_STAGE(PG8_SA(0, 1), a2 + hstepA, voffA);
            PG8_WAIT_V(8); PG8_WAIT_L(0); PG8_BAR; PG8_MMA(0, 0, At, B0); PG8_MMA(0, 1, At, B1); PG8_BAR; PG8_SCHED;
            PG8_LDA(At, 1, 1); PG8_STAGE(PG8_SB(1, 0), b3, voffB); PG8_STAGE(PG8_SB(1, 1), b3 + hstepB, voffB); PG8_STAGE(PG8_SA(1, 0), a3, voffA);
            PG8_WAIT_V(8); PG8_WAIT_L(0); PG8_BAR; PG8_MMA(1, 0, At, B0); PG8_MMA(1, 1, At, B1); PG8_BAR; PG8_SCHED;
            } else {
            PG8_LDB(B0, 0, 0); PG8_SCHED; PG8_LDA(At, 0, 0); PG8_STAGE(PG8_SA(1, 1), a1 + hstepA, voffA);
            PG8_WAIT_L(8); PG8_BAR; PG8_WAIT_L(0); PG8_MMA(0, 0, At, B0); PG8_BAR; PG8_SCHED;
            PG8_LDB(B1, 0, 1); PG8_STAGE(PG8_SB(0, 0), b2, voffB);
            PG8_BAR; PG8_WAIT_L(0); PG8_MMA(0, 1, At, B1); PG8_BAR;
            PG8_LDA(At, 0, 1); PG8_STAGE(PG8_SA(0, 0), a2, voffA);
            PG8_BAR; PG8_WAIT_L(0); PG8_MMA(1, 0, At, B0); PG8_BAR; PG8_SCHED;
            PG8_STAGE(PG8_SB(0, 1), b2 + hstepB, voffB);
            PG8_WAIT_V(6); PG8_BAR; PG8_MMA(1, 1, At, B1); PG8_BAR;
            PG8_LDB(B0, 1, 0); PG8_SCHED; PG8_LDA(At, 1, 0); PG8_STAGE(PG8_SA(0, 1), a2 + hstepA, voffA);
            PG8_WAIT_L(8); PG8_BAR; PG8_WAIT_L(0); PG8_MMA(0, 0, At, B0); PG8_BAR; PG8_SCHED;
            PG8_LDB(B1, 1, 1); PG8_STAGE(PG8_SB(1, 0), b3, voffB);
            PG8_BAR; PG8_WAIT_L(0); PG8_MMA(0, 1, At, B1); PG8_BAR;
            PG8_LDA(At, 1, 1); PG8_STAGE(PG8_SA(1, 0), a3, voffA);
            PG8_BAR; PG8_WAIT_L(0); PG8_MMA(1, 0, At, B0); PG8_BAR; PG8_SCHED;
            PG8_STAGE(PG8_SB(1, 1), b3 + hstepB, voffB);
            PG8_WAIT_V(6); PG8_BAR; PG8_MMA(1, 1, At, B1); PG8_BAR;
            }
        }
        if constexpr (ALIGN_EPI) { if (wr == 0) PG8_BAR; }
        if constexpr (!Epi::AFTER_DRAIN) { E(acc, cur, wr, wc, fr, fq); S.done(cur); }
        if (!has_next) break;
#pragma unroll
        for (int a = 0; a < 2; ++a)
#pragma unroll
            for (int b = 0; b < 2; ++b)
#pragma unroll
                for (int m = 0; m < 4; ++m)
#pragma unroll
                    for (int n = 0; n < 2; ++n) acc[a][b][m][n] = (f32x4){0.f, 0.f, 0.f, 0.f};
        cur = nxt; cA = nA; cB = nB; ++ui;
        if constexpr (ALIGN_EPI) { if (wr == 1) PG8_BAR; }
    }
    PG8_WAIT_V(0);
    if constexpr (!ALIGN_EPI) { if (wr == 0) PG8_BAR; }
    PG8_BAR;
    if constexpr (Epi::AFTER_DRAIN) { E.fused(acc, cur, wr, wc, fr, fq, lds, wid, lane); S.done(cur); }
#undef PG8_SA
#undef PG8_SB
#undef PG8_STAGE
#undef PG8_LDA
#undef PG8_LDB
#undef PG8_MMA
#undef PG8_WAIT_V
#undef PG8_WAIT_L
#undef PG8_BAR
#undef PG8_SCHED
}
}

namespace att {
using bf16x8 = __attribute__((ext_vector_type(8))) short;
using s16x4  = __attribute__((ext_vector_type(4))) short;
using f32x16 = __attribute__((ext_vector_type(16))) float;
using u32x4  = __attribute__((ext_vector_type(4))) unsigned;
typedef unsigned short bf16_t;
constexpr int DQK = 192, DV = 128, NW = 8, QBLK = 32, KVBLK = 64;
constexpr int LDQ = 768, LDK = 768, LDV = 512, LDY = 1024;
constexpr float THR = 11.5f;
constexpr int KROW = 400;
constexpr int SHM_V = KVBLK * DV * 2, SHM_K = KVBLK * KROW;
constexpr int SHM_ATTN = 2 * SHM_V + 2 * SHM_K + NW * 96 * 4;
#define KSWZ(row, colB) ((row) * KROW + (colB))
#define SBAR() __builtin_amdgcn_sched_barrier(0)
__device__ __forceinline__ int crow(int r, int hi) { return (r & 3) + 8 * (r >> 2) + 4 * hi; }
__device__ __forceinline__ unsigned cvtpk(float lo, float hi) { unsigned r; asm volatile("v_cvt_pk_bf16_f32 %0, %1, %2" : "=v"(r) : "v"(lo), "v"(hi)); return r; }

__device__ __forceinline__ void partialSM(f32x16& p0, f32x16& p1, float& m_reg, float& mn, float& alpha) {
  float pmax = p0[0];
#pragma unroll
  for (int r = 1; r < 16; ++r) pmax = fmaxf(pmax, p0[r]);
#pragma unroll
  for (int r = 0; r < 16; ++r) pmax = fmaxf(pmax, p1[r]);
  { auto rr = __builtin_amdgcn_permlane32_swap(__float_as_uint(pmax), __float_as_uint(pmax), false, false);
    pmax = fmaxf(__uint_as_float(rr[0]), __uint_as_float(rr[1])); }
  if (__builtin_expect(__all(pmax - m_reg <= THR), 1)) { mn = m_reg; alpha = 1.f; }
  else { mn = fmaxf(m_reg, pmax); alpha = __builtin_amdgcn_exp2f(m_reg - mn); m_reg = mn; }
#pragma unroll
  for (int r = 0; r < 16; ++r) p0[r] = p0[r] - mn;
#pragma unroll
  for (int r = 0; r < 16; ++r) p1[r] = p1[r] - mn;
#pragma unroll
  for (int r = 0; r < 16; ++r) p0[r] = __builtin_amdgcn_exp2f(p0[r]);
}
__device__ __forceinline__ void finishSM(f32x16& p0, f32x16& p1, float alpha, float& l_reg, bf16x8& pa0, bf16x8& pa1, bf16x8& pa2, bf16x8& pa3) {
#pragma unroll
  for (int r = 0; r < 16; ++r) p1[r] = __builtin_amdgcn_exp2f(p1[r]);
  float ps = 0;
#pragma unroll
  for (int r = 0; r < 16; ++r) ps += p0[r];
#pragma unroll
  for (int r = 0; r < 16; ++r) ps += p1[r];
  { auto rr = __builtin_amdgcn_permlane32_swap(__float_as_uint(ps), __float_as_uint(ps), false, false);
    ps = __uint_as_float(rr[0]) + __uint_as_float(rr[1]); }
  l_reg = l_reg * alpha + ps;
#define PK4(P, BASE, OUT) do { unsigned a0 = cvtpk(P[BASE + 0], P[BASE + 1]), a1 = cvtpk(P[BASE + 2], P[BASE + 3]);   \
    unsigned b0 = cvtpk(P[BASE + 4], P[BASE + 5]), b1 = cvtpk(P[BASE + 6], P[BASE + 7]);                              \
    auto r0 = __builtin_amdgcn_permlane32_swap(a0, b0, false, false); auto r1 = __builtin_amdgcn_permlane32_swap(a1, b1, false, false); \
    u32x4 w = {r0[0], r1[0], r0[1], r1[1]}; OUT = *reinterpret_cast<bf16x8*>(&w); } while (0)
  PK4(p0, 0, pa0); PK4(p0, 8, pa1); PK4(p1, 0, pa2); PK4(p1, 8, pa3);
#undef PK4
}
__device__ __forceinline__ void qkt(f32x16& p0, f32x16& p1, const char* Ks, const bf16x8* qr, int r32, int hi) {
  p0 = f32x16{}; p1 = f32x16{};
  const char* kb = Ks + r32 * KROW + hi * 16;
#pragma unroll
  for (int d0 = 0; d0 < 12; ++d0) {
    bf16x8 b0 = *reinterpret_cast<const bf16x8*>(kb + d0 * 32);
    bf16x8 b1 = *reinterpret_cast<const bf16x8*>(kb + 32 * KROW + d0 * 32);
    p0 = __builtin_amdgcn_mfma_f32_32x32x16_bf16(b0, qr[d0], p0, 0, 0, 0);
    p1 = __builtin_amdgcn_mfma_f32_32x32x16_bf16(b1, qr[d0], p1, 0, 0, 0); }
}
__device__ __forceinline__ int v_st(int k, int c) { const int kk = (k & ~0xC) | ((k & 4) << 1) | ((k & 8) >> 1); return ((kk >> 3) * 4 + (c >> 5)) * 512 + ((kk & 7) * 32 + (c & 31)) * 2; }
__device__ __forceinline__ int v_rd_base(int lane) { return ((lane & 3) << 3) | (((lane >> 2) & 3) << 6) | (((lane >> 4) & 1) << 5) | (((lane >> 5) & 1) << 8); }
constexpr int v_rd_off(int d0, int ks, int half) { return d0 * 512 + ks * 4096 + half * 2048; }
template <int OFF> __device__ __forceinline__ s16x4 tr_read(int vb) {
  s16x4 r; asm volatile("ds_read_b64_tr_b16 %0, %1 offset:%2" : "=&v"(r) : "v"(vb), "i"(OFF) : "memory"); return r;
}
#define PKV(L, H) (bf16x8){L[0], L[1], L[2], L[3], H[0], H[1], H[2], H[3]}
template <int D0> __device__ __forceinline__ void pv_one(f32x16& od, int vb, bf16x8 pa0, bf16x8 pa1, bf16x8 pa2, bf16x8 pa3) {
  const s16x4 l0 = tr_read<v_rd_off(D0, 0, 0)>(vb), h0 = tr_read<v_rd_off(D0, 0, 1)>(vb), l1 = tr_read<v_rd_off(D0, 1, 0)>(vb), h1 = tr_read<v_rd_off(D0, 1, 1)>(vb);
  const s16x4 l2 = tr_read<v_rd_off(D0, 2, 0)>(vb), h2 = tr_read<v_rd_off(D0, 2, 1)>(vb), l3 = tr_read<v_rd_off(D0, 3, 0)>(vb), h3 = tr_read<v_rd_off(D0, 3, 1)>(vb);
  asm volatile("s_waitcnt lgkmcnt(0)" ::: "memory"); SBAR();
  od = __builtin_amdgcn_mfma_f32_32x32x16_bf16(pa0, PKV(l0, h0), od, 0, 0, 0);
  od = __builtin_amdgcn_mfma_f32_32x32x16_bf16(pa1, PKV(l1, h1), od, 0, 0, 0);
  od = __builtin_amdgcn_mfma_f32_32x32x16_bf16(pa2, PKV(l2, h2), od, 0, 0, 0);
  od = __builtin_amdgcn_mfma_f32_32x32x16_bf16(pa3, PKV(l3, h3), od, 0, 0, 0);
}
__device__ __forceinline__ void pv_d0(f32x16* o, int vb, bf16x8 pa0, bf16x8 pa1, bf16x8 pa2, bf16x8 pa3) {
  pv_one<0>(o[0], vb, pa0, pa1, pa2, pa3); pv_one<1>(o[1], vb, pa0, pa1, pa2, pa3); pv_one<2>(o[2], vb, pa0, pa1, pa2, pa3); pv_one<3>(o[3], vb, pa0, pa1, pa2, pa3);
}

__device__ __forceinline__ void attn_head(const bf16_t* __restrict__ Qb, const bf16_t* __restrict__ Kh, const bf16_t* __restrict__ Vh, bf16_t* Yb, int seq, char* lds) {
  int tid_ = threadIdx.x; asm volatile("" : "+v"(tid_));
  const int tid = tid_, wid = __builtin_amdgcn_readfirstlane(tid >> 6), lane = tid & 63, r32 = lane & 31, hi = lane >> 5;
  char* V_lds = lds; char* K_lds = lds + 2 * SHM_V;
  float* ws = (float*)(lds + 2 * SHM_V + 2 * SHM_K) + wid * 96; float* li_l = ws; float* al_l = ws + 32;
  float m_reg = -1e30f, l_reg = 0; f32x16 o[4] = {}; bf16x8 qr[12];
  const bf16_t* Qw = Qb + (long)(wid * QBLK + r32) * LDQ + hi * 8;
#pragma unroll
  for (int d0 = 0; d0 < 12; ++d0) qr[d0] = *reinterpret_cast<const bf16x8*>(Qw + d0 * 16);
  const int sr = tid >> 4, sc = (tid & 15) * 8, vst0 = v_st(sr, sc), vst1 = v_st(32 + sr, sc);
  int kgo[3], klo[3];
#pragma unroll
  for (int i = 0; i < 3; ++i) { const int idx = tid + 512 * i, row = idx / 24, g = idx % 24; kgo[i] = row * LDK + g * 8; klo[i] = KSWZ(row, g * 16); }
  const int vb0 = (int)(uintptr_t)V_lds + v_rd_base(lane);
  struct { bf16x8 vs0, vs1, ks0, ks1, ks2; } sr_[1];
#define SLOAD(i, k0) do { sr_[i].vs0 = *reinterpret_cast<const bf16x8*>(&Vh[(long)((k0) + sr) * LDV + sc]); sr_[i].vs1 = *reinterpret_cast<const bf16x8*>(&Vh[(long)((k0) + 32 + sr) * LDV + sc]); \
    sr_[i].ks0 = *reinterpret_cast<const bf16x8*>(&Kh[(long)(k0) * LDK + kgo[0]]); sr_[i].ks1 = *reinterpret_cast<const bf16x8*>(&Kh[(long)(k0) * LDK + kgo[1]]); \
    sr_[i].ks2 = *reinterpret_cast<const bf16x8*>(&Kh[(long)(k0) * LDK + kgo[2]]); } while (0)
#define SWRITE(b, i) do { *(bf16x8*)(V_lds + (b) * SHM_V + vst0) = sr_[i].vs0; *(bf16x8*)(V_lds + (b) * SHM_V + vst1) = sr_[i].vs1; \
    *(bf16x8*)(K_lds + (b) * SHM_K + klo[0]) = sr_[i].ks0; *(bf16x8*)(K_lds + (b) * SHM_K + klo[1]) = sr_[i].ks1; *(bf16x8*)(K_lds + (b) * SHM_K + klo[2]) = sr_[i].ks2; } while (0)
#define SWAIT() asm volatile("s_waitcnt vmcnt(0)" ::: "memory")
#define RESC(a) do { if (__any((a) < 1.f)) { if (hi == 0) al_l[r32] = (a); asm volatile("s_waitcnt lgkmcnt(0)" ::: "memory"); \
    _Pragma("unroll") for (int d = 0; d < 4; ++d) _Pragma("unroll") for (int r = 0; r < 16; ++r) o[d][r] *= al_l[crow(r, hi)]; } } while (0)
  f32x16 pA0, pA1, pB0, pB1; float mnA, mnB, alA, alB; bf16x8 pa0, pa1, pa2, pa3; const int NT = seq / KVBLK;
  constexpr int SE = 0, SO = 0;
  SLOAD(SE, 0); asm volatile("s_waitcnt vmcnt(0)" ::: "memory"); SWRITE(0, SE); __syncthreads();
  qkt(pA0, pA1, K_lds, qr, r32, hi); partialSM(pA0, pA1, m_reg, mnA, alA);
  SLOAD(SO, KVBLK);
  SWAIT(); SWRITE(1, SO); __syncthreads();
  for (int j = 1; j + 1 < NT; j += 2) {
    SBAR(); qkt(pB0, pB1, K_lds + SHM_K, qr, r32, hi);
    finishSM(pA0, pA1, alA, l_reg, pa0, pa1, pa2, pa3); SBAR();
    SLOAD(SE, (j + 1) * KVBLK); SBAR();
    pv_d0(o, vb0, pa0, pa1, pa2, pa3); partialSM(pB0, pB1, m_reg, mnB, alB);
    __syncthreads(); SWAIT(); SWRITE(0, SE);
    RESC(alB); __syncthreads();
    SBAR(); qkt(pA0, pA1, K_lds, qr, r32, hi);
    finishSM(pB0, pB1, alB, l_reg, pa0, pa1, pa2, pa3); SBAR();
    SLOAD(SO, (j + 2) * KVBLK); SBAR();
    pv_d0(o, vb0 + SHM_V, pa0, pa1, pa2, pa3); partialSM(pA0, pA1, m_reg, mnA, alA);
    __syncthreads(); SWAIT(); SWRITE(1, SO);
    RESC(alA); __syncthreads();
  }
  SBAR(); qkt(pB0, pB1, K_lds + SHM_K, qr, r32, hi);
  finishSM(pA0, pA1, alA, l_reg, pa0, pa1, pa2, pa3); SBAR();
  pv_d0(o, vb0, pa0, pa1, pa2, pa3); partialSM(pB0, pB1, m_reg, mnB, alB);
  __syncthreads(); RESC(alB);
  finishSM(pB0, pB1, alB, l_reg, pa0, pa1, pa2, pa3); SBAR();
  pv_d0(o, vb0 + SHM_V, pa0, pa1, pa2, pa3);
  if (hi == 0) li_l[r32] = l_reg; asm volatile("s_waitcnt lgkmcnt(0)" ::: "memory");
  bf16_t* stg = (bf16_t*)(lds + SHM_ATTN) + wid * 4096;
#pragma unroll
  for (int r = 0; r < 16; ++r) { const int orow = crow(r, hi); const float rl = __builtin_amdgcn_rcpf(li_l[orow]);
#pragma unroll
    for (int d0 = 0; d0 < 4; ++d0) stg[orow * 128 + d0 * 32 + r32] = (bf16_t)(cvtpk(o[d0][r] * rl, 0.f) & 0xffffu); }
  asm volatile("s_waitcnt lgkmcnt(0)" ::: "memory");
  int le = threadIdx.x & 63; asm volatile("" : "+v"(le));
  bf16_t* Yw = Yb + (long)(wid * QBLK + (le >> 4)) * LDY + (le & 15) * 8; float* sq_l = ws + 64;
#pragma unroll
  for (int i = 0; i < 8; ++i) { const u32x4 v = *(const u32x4*)(stg + (i * 4 + (le >> 4)) * 128 + (le & 15) * 8); float s = 0.f;
#pragma unroll
    for (int e = 0; e < 4; ++e) { const float a = __uint_as_float(v[e] << 16), b = __uint_as_float(v[e] & 0xffff0000u); s += a * a + b * b; }
    s += __shfl_xor(s, 1); s += __shfl_xor(s, 2); s += __shfl_xor(s, 4); s += __shfl_xor(s, 8);
    if ((le & 15) == 0) sq_l[i * 4 + (le >> 4)] += s;
    *(u32x4*)(Yw + (long)(i * 4) * LDY) = v; }
  __syncthreads();
#undef SLOAD
#undef SWRITE
#undef SWAIT
#undef RESC
}
__device__ __forceinline__ void attn_unit(const bf16_t* Q, const bf16_t* KF, const bf16_t* VF, bf16_t* Y, const float* gb, int rowbase, int q0, int seq, char* lds) {
  int tid_ = threadIdx.x; asm volatile("" : "+v"(tid_));
  const int tid = tid_, wid = __builtin_amdgcn_readfirstlane(tid >> 6); int lane = tid & 63;
  float* sq_l = (float*)(lds + 2 * SHM_V + 2 * SHM_K) + wid * 96 + 64;
  if (lane < 32) sq_l[lane] = 0.f;
#pragma unroll 1
  for (int h = 0; h < 4; ++h)
    attn_head(Q + (long)(rowbase + q0) * LDQ + h * DQK, KF + (long)rowbase * LDK + h * DQK, VF + (long)rowbase * LDV + h * DV, Y + (long)(rowbase + q0) * LDY + 512 + h * DV, seq, lds);
  asm volatile("" : "+v"(lane));
  float ssq[8];
#pragma unroll
  for (int i = 0; i < 8; ++i) ssq[i] = __builtin_amdgcn_rsqf(sq_l[i * 4 + (lane >> 4)] * (1.0f / 512.0f) + 1e-6f);
  bf16_t* Yw = Y + (long)(rowbase + q0 + wid * QBLK + (lane >> 4)) * LDY + 512 + (lane & 15) * 8;
#pragma unroll 1
  for (int h = 0; h < 4; ++h) { const float* gp = gb + h * 128 + (lane & 15) * 8; const pg8::f32x4 g0 = *(const pg8::f32x4*)gp, g1 = *(const pg8::f32x4*)(gp + 4);
#pragma unroll
    for (int i = 0; i < 8; ++i) { bf16_t* p = Yw + (long)(i * 4) * LDY + h * 128; const u32x4 v = *(const u32x4*)p; const float rs = ssq[i]; u32x4 w;
      w.x = cvtpk(__uint_as_float(v.x << 16) * rs * g0[0], __uint_as_float(v.x & 0xffff0000u) * rs * g0[1]); w.y = cvtpk(__uint_as_float(v.y << 16) * rs * g0[2], __uint_as_float(v.y & 0xffff0000u) * rs * g0[3]);
      w.z = cvtpk(__uint_as_float(v.z << 16) * rs * g1[0], __uint_as_float(v.z & 0xffff0000u) * rs * g1[1]); w.w = cvtpk(__uint_as_float(v.w << 16) * rs * g1[2], __uint_as_float(v.w & 0xffff0000u) * rs * g1[3]);
      *(u32x4*)p = w; } }
}
#undef KSWZ
#undef SBAR
#undef PKV
}

namespace sgu {
using att::bf16x8; using att::s16x4; using att::f32x16; using att::bf16_t;
typedef unsigned u32x2 __attribute__((ext_vector_type(2)));
__device__ __forceinline__ float bf2f(unsigned short b) { return __uint_as_float((unsigned)b << 16); }
#define SG_PK(L, H) (bf16x8){L[0], L[1], L[2], L[3], H[0], H[1], H[2], H[3]}
template <int KS, int J> __device__ __forceinline__ bf16x8 vfrag(int vbh) {
  const s16x4 l = att::tr_read<(KS >> 2) * 16384 + J * 512 + (KS & 3) * 4096>(vbh), h = att::tr_read<(KS >> 2) * 16384 + J * 512 + (KS & 3) * 4096 + 2048>(vbh);
  asm volatile("s_waitcnt lgkmcnt(0)" ::: "memory"); return SG_PK(l, h);
}
__device__ __forceinline__ void sgu_unit(const bf16_t* __restrict__ Z, const bf16_t* __restrict__ Ws, const float* __restrict__ bsp, const float* __restrict__ gsgu, const float* __restrict__ ga,
                                         bf16_t* __restrict__ Y, int chunk, char* lds) {
  int tid_ = threadIdx.x; asm volatile("" : "+v"(tid_));
  const int tid = tid_, wid = __builtin_amdgcn_readfirstlane(tid >> 6), lane = tid & 63, r32 = lane & 31, hi = lane >> 5;
  const long row0 = (long)chunk * 128;
#pragma unroll 1
  for (int it = 0; it < 4; ++it) {
    bf16x8 raw[4];
#pragma unroll
    for (int i = 0; i < 4; ++i) { const int idx = tid + 512 * (it * 4 + i), row = idx >> 6, g = idx & 63; raw[i] = *reinterpret_cast<const bf16x8*>(Z + (row0 + row) * 1792 + 512 + g * 8); }
#pragma unroll
    for (int i = 0; i < 4; ++i) { const int idx = tid + 512 * (it * 4 + i), row = idx >> 6, g = idx & 63;
      float f[8]; float ss = 0.f;
#pragma unroll
      for (int e = 0; e < 8; ++e) { f[e] = bf2f((unsigned short)raw[i][e]); ss += f[e] * f[e]; }
      ss += __shfl_xor(ss, 1); ss += __shfl_xor(ss, 2); ss += __shfl_xor(ss, 4); ss += __shfl_xor(ss, 8);
      const float rs = __builtin_amdgcn_rsqf(ss * (1.0f / 128.0f) + 1e-6f);
      const pg8::f32x4 g0 = *(const pg8::f32x4*)(gsgu + g * 8), g1 = *(const pg8::f32x4*)(gsgu + g * 8 + 4);
      pg8::f32x4 a = {f[0] * rs * g0[0], f[1] * rs * g0[1], f[2] * rs * g0[2], f[3] * rs * g0[3]}, b = {f[4] * rs * g1[0], f[5] * rs * g1[1], f[6] * rs * g1[2], f[7] * rs * g1[3]};
      const pg8::u32x4 w = pg8::pack8(a, b);
      *(pg8::u32x4*)(lds + ((g >> 4) * 2 + (row >> 6)) * 16384 + att::v_st(row & 63, (g & 15) * 8)) = w; }
  }
  __syncthreads();
  const int pb = wid >> 1, dsel = wid & 1;
  const int vb = (int)(uintptr_t)lds + att::v_rd_base(lane) + dsel * 1024;
  const long row = row0 + 32 * pb + r32;
  float yreg[4][2][16]; float ssq = 0.f;
#pragma unroll
  for (int h = 0; h < 4; ++h) {
    f32x16 acc0 = {}, acc1 = {};
    const bf16_t* wp = Ws + (long)(h * 128 + 32 * pb + r32) * 128 + 8 * hi;
    const int vbh = vb + h * 32768;
#define SG_STEP(KS) do { const bf16x8 wf = *reinterpret_cast<const bf16x8*>(wp + 16 * KS); const bf16x8 v0 = vfrag<KS, 0>(vbh), v1 = vfrag<KS, 1>(vbh); \
      acc0 = __builtin_amdgcn_mfma_f32_32x32x16_bf16(v0, wf, acc0, 0, 0, 0); acc1 = __builtin_amdgcn_mfma_f32_32x32x16_bf16(v1, wf, acc1, 0, 0, 0); } while (0)
    SG_STEP(0); SG_STEP(1); SG_STEP(2); SG_STEP(3); SG_STEP(4); SG_STEP(5); SG_STEP(6); SG_STEP(7);
#undef SG_STEP
    const float bb = bsp[h * 128 + 32 * pb + r32];
#pragma unroll
    for (int j = 0; j < 2; ++j)
#pragma unroll
      for (int rq = 0; rq < 4; ++rq) { const int d = 32 * (2 * dsel + j) + 8 * rq + 4 * hi;
        const u32x2 uu = *reinterpret_cast<const u32x2*>(Z + row * 1792 + h * 128 + d);
        const float u0 = __uint_as_float(uu.x << 16), u1 = __uint_as_float(uu.x & 0xffff0000u), u2 = __uint_as_float(uu.y << 16), u3 = __uint_as_float(uu.y & 0xffff0000u);
        const f32x16& ac = j ? acc1 : acc0;
        const float y0 = (ac[4 * rq + 0] + bb) * u0, y1 = (ac[4 * rq + 1] + bb) * u1, y2 = (ac[4 * rq + 2] + bb) * u2, y3 = (ac[4 * rq + 3] + bb) * u3;
        yreg[h][j][4 * rq + 0] = y0; yreg[h][j][4 * rq + 1] = y1; yreg[h][j][4 * rq + 2] = y2; yreg[h][j][4 * rq + 3] = y3;
        ssq += (y0 * y0 + y1 * y1) + (y2 * y2 + y3 * y3); }
  }
  ssq += __shfl_xor(ssq, 32);
  float* xs = (float*)(lds + 131072);
  if (hi == 0) xs[wid * 32 + r32] = ssq;
  __syncthreads();
  const float tot = xs[wid * 32 + r32] + xs[(wid ^ 1) * 32 + r32];
  const float rs = __builtin_amdgcn_rsqf(tot * (1.0f / 512.0f) + 1e-6f);
#pragma unroll
  for (int h = 0; h < 4; ++h)
#pragma unroll
    for (int j = 0; j < 2; ++j)
#pragma unroll
      for (int rq = 0; rq < 4; ++rq) { const int c = h * 128 + 32 * (2 * dsel + j) + 8 * rq + 4 * hi; const pg8::f32x4 gg = *(const pg8::f32x4*)(ga + c);
        u32x2 w; w.x = pg8::cvt_pk_bf16(yreg[h][j][4 * rq + 0] * rs * gg[0], yreg[h][j][4 * rq + 1] * rs * gg[1]); w.y = pg8::cvt_pk_bf16(yreg[h][j][4 * rq + 2] * rs * gg[2], yreg[h][j][4 * rq + 3] * rs * gg[3]);
        *reinterpret_cast<u32x2*>(Y + row * 1024 + c) = w; }
  __syncthreads();
}
#undef SG_PK
}

typedef unsigned short bf16;
typedef float f32x4 __attribute__((ext_vector_type(4)));
typedef unsigned v4u __attribute__((ext_vector_type(4)));
#define LAS __attribute__((address_space(3)))
constexpr int M_P = 8 * 4096, M_S = 32 * 2048, M = M_P + M_S;
constexpr int DM = 1024, NZ = 1792, FF = 4096;
constexpr size_t MiB = 1u << 20;
constexpr size_t WS_WIN = 1 * MiB, WS_WUQ = 5 * MiB, WS_WUKV = 6 * MiB, WS_WOUT = 7 * MiB, WS_W1 = 9 * MiB, WS_W2 = 17 * MiB, WS_WS = 25 * MiB, WS_ROPEC = 26 * MiB, WS_ROPES = 27 * MiB;
constexpr size_t WS_ST1 = 28 * MiB, WS_ST2 = 36 * MiB;
constexpr size_t WS_XN = 48 * MiB;
constexpr size_t WS_Z = 240 * MiB, WS_KF = 576 * MiB, WS_VF = 720 * MiB, WS_Y = 816 * MiB;
constexpr size_t WS_F = 240 * MiB, WS_END = 1008 * MiB;
constexpr int LDS_BYTES = att::SHM_ATTN + 65536 > 131072 + 4096 ? att::SHM_ATTN + 65536 : 131072 + 4096;
constexpr int NWAVES = 8;

__device__ __forceinline__ unsigned f2bf(float f) { unsigned u = __builtin_bit_cast(unsigned, f); return (u + 0x7fffu + ((u >> 16) & 1u)) >> 16; }
__device__ __forceinline__ unsigned pk2(float lo, float hi) { return f2bf(lo) | (f2bf(hi) << 16); }
__device__ __forceinline__ float wave_sum(float v) {
#pragma unroll
    for (int o = 1; o < 64; o <<= 1) v += __shfl_xor(v, o);
    return v;
}
__device__ __forceinline__ int colmap(int mode, int nd) {
    if (mode == 1) { if (nd < 1664) return nd; if (nd < 1728) { const int j = nd - 1664; return 1664 + (j & 1) * 32 + (j >> 1); } return -1; }
    if (mode == 2) { const int h = nd / 192, d = nd % 192; if (d < 128) return nd; const int j = d - 128; return h * 192 + 128 + (j & 1) * 32 + (j >> 1); }
    if (mode == 3) { const int t = nd >> 9, hh = (nd >> 7) & 3, d = nd & 127; return hh * 256 + t * 128 + d; }
    return nd;
}
__device__ __forceinline__ void transpose_item(const float* W, int K, int N, int Npad, bf16* WT, const float* gain, int mode, LAS float* scr, int item, int lane) {
    const int nblk = Npad / 32, kb = item / nblk, nb = item % nblk, k0 = 64 * kb, n0 = 32 * nb;
    const int src = colmap(mode, n0 + (lane & 31));
#pragma unroll 8
    for (int i = 0; i < 32; ++i) { const int kk = 2 * i + (lane >> 5); float v = 0.f; if (src >= 0) { v = W[(size_t)(k0 + kk) * N + src]; if (gain) v *= gain[k0 + kk]; } scr[kk * 33 + (lane & 31)] = v; }
    asm volatile("s_waitcnt lgkmcnt(0)" ::: "memory");
    const int c = lane & 7;
#pragma unroll
    for (int j = 0; j < 4; ++j) { const int n = (lane >> 3) + 8 * j; const LAS float* s = scr + (8 * c) * 33 + n;
        v4u o; o.x = pk2(s[0 * 33], s[1 * 33]); o.y = pk2(s[2 * 33], s[3 * 33]); o.z = pk2(s[4 * 33], s[5 * 33]); o.w = pk2(s[6 * 33], s[7 * 33]);
        *(v4u*)(WT + (size_t)(n0 + n) * K + k0 + 8 * c) = o; }
    asm volatile("s_waitcnt lgkmcnt(0)" ::: "memory");
}
struct Params { const float* in[18]; float* out; unsigned char* ws; int ph_lo, ph_hi; };
enum { I_XP = 0, I_XS, I_NMIX, I_WIN, I_SGUN, I_WSP, I_BSP, I_QN, I_WUQ, I_KVN, I_WUKV, I_ONA, I_ONB, I_WOUT, I_NFFN, I_W1, I_W2, I_NFIN };

__global__ void __launch_bounds__(NWAVES * 64, 2) mega_fwd(Params p) {
    extern __shared__ __attribute__((aligned(16))) unsigned char lds[];
    namespace cg = cooperative_groups;
    const int tid = threadIdx.x, lane = tid & 63, wave = __builtin_amdgcn_readfirstlane(tid >> 6);
    const int G = gridDim.x, bx = blockIdx.x;
    const int vcu = (G % 8 == 0) ? (bx % 8) * (G / 8) + bx / 8 : bx;
    unsigned char* ws = p.ws;
    bf16* Win_t = (bf16*)(ws + WS_WIN); bf16* Wuq_t = (bf16*)(ws + WS_WUQ); bf16* Wukv_t = (bf16*)(ws + WS_WUKV); bf16* Wout_t = (bf16*)(ws + WS_WOUT);
    bf16* W1_t = (bf16*)(ws + WS_W1); bf16* W2_t = (bf16*)(ws + WS_W2); bf16* Wsb = (bf16*)(ws + WS_WS);
    float* ropec = (float*)(ws + WS_ROPEC); float* ropes = (float*)(ws + WS_ROPES); float* stat1 = (float*)(ws + WS_ST1); float* stat2 = (float*)(ws + WS_ST2);
    bf16* XN = (bf16*)(ws + WS_XN); bf16* Qb = XN; bf16* XB = XN;
    bf16* Z = (bf16*)(ws + WS_Z); bf16* KF = (bf16*)(ws + WS_KF); bf16* VF = (bf16*)(ws + WS_VF); bf16* Y = (bf16*)(ws + WS_Y); bf16* Fb = (bf16*)(ws + WS_F);
    const int lo = p.ph_lo, hi_ = p.ph_hi;
#ifndef PHMASK
#define PHMASK 0xFF
#endif
#define IN(k) ((((PHMASK) >> (k)) & 1) && lo <= (k) && (k) < hi_)
#define SEAM(k) do { if (IN(k) && IN((k) + 1)) { __threadfence(); cg::this_grid().sync(); } } while (0)
    const int gw = vcu * NWAVES + wave, NGW = G * NWAVES;

    if (IN(0)) {
        LAS float* scr = (LAS float*)((LAS unsigned char*)lds + wave * 16384);
        constexpr int I_A = 16 * 56, I_B = 6 * 24, I_C = 4 * 32, I_D = 16 * 32, I_E = 16 * 128, I_F = 64 * 32;
        for (int it = gw; it < I_A + I_B + I_C + I_D + I_E + I_F; it += NGW) {
            int r = it;
            if (r < I_A) { transpose_item(p.in[I_WIN], 1024, 1728, 1792, Win_t, p.in[I_NMIX], 1, scr, r, lane); continue; } r -= I_A;
            if (r < I_B) { transpose_item(p.in[I_WUQ], 384, 768, 768, Wuq_t, p.in[I_QN], 2, scr, r, lane); continue; } r -= I_B;
            if (r < I_C) { transpose_item(p.in[I_WUKV], 256, 1024, 1024, Wukv_t, p.in[I_KVN], 3, scr, r, lane); continue; } r -= I_C;
            if (r < I_D) { transpose_item(p.in[I_WOUT], 1024, 1024, 1024, Wout_t, nullptr, 0, scr, r, lane); continue; } r -= I_D;
            if (r < I_E) { transpose_item(p.in[I_W1], 1024, 4096, 4096, W1_t, p.in[I_NFFN], 0, scr, r, lane); continue; } r -= I_E;
            transpose_item(p.in[I_W2], 4096, 1024, 1024, W2_t, nullptr, 0, scr, r, lane);
        }
        for (int i = bx * 512 + tid; i < 4 * 128 * 128 / 2; i += G * 512) { const float a = p.in[I_WSP][2 * i], b = p.in[I_WSP][2 * i + 1]; ((unsigned*)Wsb)[i] = pk2(a, b); }
        for (int i = bx * 512 + tid; i < 4096 * 32; i += G * 512) { const int pos = i >> 5, k = i & 31;
            const float inv = __builtin_amdgcn_exp2f(-(float)k * 0.41524101186092029f); const float ang = (float)pos * inv;
            const double t = (double)ang * 0.15915494309189535; const float fr = (float)(t - __builtin_floor(t));
            ropec[i] = __builtin_amdgcn_cosf(fr); ropes[i] = __builtin_amdgcn_sinf(fr); }
        for (int m = gw; m < M; m += NGW) {
            const float* xrow = (m < M_P) ? p.in[I_XP] + (size_t)m * DM : p.in[I_XS] + (size_t)(m - M_P) * DM;
            const f32x4* xr = (const f32x4*)xrow + lane; f32x4 v[4]; float s = 0.f;
#pragma unroll
            for (int j = 0; j < 4; ++j) { v[j] = xr[64 * j]; s += (v[j].x * v[j].x + v[j].y * v[j].y) + (v[j].z * v[j].z + v[j].w * v[j].w); }
            const float rstd = __builtin_amdgcn_rsqf(wave_sum(s) * (1.f / DM) + 1e-6f);
            unsigned long long* o8 = (unsigned long long*)(XN + (size_t)m * DM) + lane;
#pragma unroll
            for (int j = 0; j < 4; ++j) o8[64 * j] = (unsigned long long)pk2(v[j].x * rstd, v[j].y * rstd) | ((unsigned long long)pk2(v[j].z * rstd, v[j].w * rstd) << 32);
        }
    }
    SEAM(0);
    if (IN(1)) {
        pg8::Gemm g{XN, Win_t, M, NZ, DM, DM, DM}; pg8::StaticOrder S; S.init(M, NZ, G, bx);
        pg8::EpiZ E{Z, KF, stat1, ropec, ropes};
        pg8::gemm_phase<pg8::EpiZ, pg8::StaticOrder, true, true>((LAS unsigned char*)lds, g, S, E);
    }
    SEAM(1);
    if (IN(2)) {
#ifndef NO_GQ
        { pg8::Gemm g{Z + 1024, Wuq_t, M, 768, 384, NZ, 384}; pg8::StaticOrder S; S.init(M, 768, G, bx);
          pg8::EpiQ E{Qb, stat1, ropec, ropes};
          pg8::gemm_phase<pg8::EpiQ, pg8::StaticOrder, true, true>((LAS unsigned char*)lds, g, S, E); }
#endif
#ifndef NO_GKV
        { pg8::Gemm g{Z + 1408, Wukv_t, M, 1024, 256, NZ, 256}; pg8::StaticOrder S; S.init(M, 1024, G, bx);
          pg8::EpiKV E{KF, VF, stat1};
          pg8::gemm_phase<pg8::EpiKV, pg8::StaticOrder, true, true>((LAS unsigned char*)lds, g, S, E); }
#endif
        __syncthreads();
#ifndef NO_SGU
        for (int c = vcu; c < M / 128; c += G) sgu::sgu_unit(Z, Wsb, p.in[I_BSP], p.in[I_SGUN], p.in[I_ONA], Y, c, (char*)lds);
#endif
    }
    SEAM(2);
    if (IN(3)) {
        for (int it = 0;; ++it) {
            int u;
            if (G == 256) { if (vcu < 128) { if (it > 0) break; u = vcu; } else { if (it > 1) break; u = 128 + 2 * (vcu - 128) + it; } }
            else { u = bx + it * G; if (u >= 384) break; }
            const int s_ = u - 128;
            const int rowbase = (u < 128) ? (u >> 4) * 4096 : M_P + (s_ >> 3) * 2048, q0 = (u < 128) ? (u & 15) * 256 : (s_ & 7) * 256, seq = (u < 128) ? 4096 : 2048;
            att::attn_unit(Qb, KF, VF, Y, p.in[I_ONB], rowbase, q0, seq, (char*)lds);
        }
    }
    SEAM(3);
    if (IN(4)) {
        pg8::Gemm g{Y, Wout_t, M, DM, DM, DM, DM}; pg8::StaticOrder S; S.init(M, DM, G, bx);
        pg8::EpiX1 E{p.in[I_XP], p.in[I_XS], p.out, XB, stat2};
        pg8::gemm_phase<pg8::EpiX1, pg8::StaticOrder, true, true>((LAS unsigned char*)lds, g, S, E);
    }
    SEAM(4);
    if (IN(5)) {
        pg8::Gemm g{XB, W1_t, M, FF, DM, DM, DM}; pg8::StaticOrder S; S.init(M, FF, G, bx);
        pg8::EpiF E{Fb, stat2};
        pg8::gemm_phase<pg8::EpiF, pg8::StaticOrder, true, true>((LAS unsigned char*)lds, g, S, E);
    }
    SEAM(5);
    if (IN(6)) {
        pg8::Gemm g{Fb, W2_t, M, DM, FF, FF, FF}; pg8::StaticOrder S; S.init(M, DM, G, bx);
        pg8::EpiX2 E{p.out};
        pg8::gemm_phase<pg8::EpiX2, pg8::StaticOrder, true, true>((LAS unsigned char*)lds, g, S, E);
    }
    SEAM(6);
    if (IN(7)) {
        const f32x4* gf = (const f32x4*)p.in[I_NFIN] + lane;
        for (int m = gw; m < M; m += NGW) {
            f32x4* xr = (f32x4*)(p.out + (size_t)m * DM) + lane; f32x4 v[4]; float s = 0.f;
#pragma unroll
            for (int j = 0; j < 4; ++j) { v[j] = xr[64 * j]; s += (v[j].x * v[j].x + v[j].y * v[j].y) + (v[j].z * v[j].z + v[j].w * v[j].w); }
            const float rstd = __builtin_amdgcn_rsqf(wave_sum(s) * (1.f / DM) + 1e-6f);
#pragma unroll
            for (int j = 0; j < 4; ++j) xr[64 * j] = v[j] * rstd * gf[64 * j];
        }
    }
#undef IN
#undef SEAM
}

#ifndef MK_N_LAUNCHES
#define MK_N_LAUNCHES 1
#endif
extern "C" void kernel_launch(void* const* d_in, const int* in_sizes, int n_in, void* d_out, int out_size, void* d_ws, size_t ws_size, hipStream_t stream) {
    static int grid = 0;
    if (grid == 0) {
        if (n_in != 18 || in_sizes[0] != M_P * DM || in_sizes[1] != M_S * DM || out_size != M * DM || ws_size < WS_END) {
            fprintf(stderr, "kernel_launch: unexpected shapes (n_in %d, in0 %d, in1 %d, out %d, ws %zu); nothing launched\n", n_in, n_in > 0 ? in_sizes[0] : -1, n_in > 1 ? in_sizes[1] : -1, out_size, ws_size); grid = -1; return; }
        int dev = 0, cus = 0, per_cu = 0;
        if (hipGetDevice(&dev) != hipSuccess || hipDeviceGetAttribute(&cus, hipDeviceAttributeMultiprocessorCount, dev) != hipSuccess) { grid = -1; return; }
        if (hipFuncSetAttribute((const void*)mega_fwd, hipFuncAttributeMaxDynamicSharedMemorySize, LDS_BYTES) != hipSuccess) { fprintf(stderr, "kernel_launch: hipFuncSetAttribute failed\n"); grid = -1; return; }
        if (hipOccupancyMaxActiveBlocksPerMultiprocessor(&per_cu, (const void*)mega_fwd, NWAVES * 64, LDS_BYTES) != hipSuccess || per_cu < 1) { fprintf(stderr, "kernel_launch: occupancy query says %d\n", per_cu); per_cu = 1; }
        (void)hipGetLastError();
        grid = cus * per_cu;
    }
    if (grid < 0) return;
    Params a{};
    for (int i = 0; i < 18; ++i) a.in[i] = (const float*)d_in[i];
    a.out = (float*)d_out; a.ws = (unsigned char*)d_ws;
    if (MK_N_LAUNCHES == 1) {
        a.ph_lo = 0; a.ph_hi = 8;
        void* args[] = {&a};
        const hipError_t e = hipLaunchCooperativeKernel((const void*)mega_fwd, dim3(grid), dim3(NWAVES * 64), args, LDS_BYTES, stream);
        if (e != hipSuccess) fprintf(stderr, "kernel_launch: cooperative launch failed: %s (grid %d)\n", hipGetErrorString(e), grid);
    } else {
        for (int ph = 0; ph < 8; ++ph) { a.ph_lo = ph; a.ph_hi = ph + 1; hipLaunchKernelGGL(mega_fwd, dim3(grid), dim3(NWAVES * 64), LDS_BYTES, stream, a); }
    }
}
```

```cpp
#include <hip/hip_runtime.h>
#include <hip/hip_cooperative_groups.h>
#include <cstdio>
#include <cstdint>
namespace pg8 {
#define PG8_LAS __attribute__((address_space(3)))
typedef unsigned short bf16_t;
typedef short bf16x8 __attribute__((ext_vector_type(8)));
typedef float f32x4 __attribute__((ext_vector_type(4)));
typedef unsigned u32x4 __attribute__((ext_vector_type(4)));
constexpr int BM = 256, BK = 64, HALF = 128, HTB = HALF * BK * 2  , STAGE_BYTES = 8 * HTB, NXCD = 8, WGM = 8;

__host__ __device__ __forceinline__ int lds_byte(int r, int c) { const int st = (r >> 4) * 2 + (c >> 5), rr = r & 15, cc = c & 31, ob = rr * 64 + cc * 2; return st * 1024 + (ob ^ (((ob >> 9) & 1) << 5)); }
__host__ __device__ __forceinline__ void stage_rc(int b, int& R, int& C) { const int st = b / 1024, sb = b % 1024, swz = sb ^ (((sb >> 9) & 1) << 5); R = (st >> 1) * 16 + swz / 64; C = (st & 1) * 32 + (swz % 64) / 2; }
__host__ __device__ __forceinline__ int perm32(int rho) { const int n = rho >> 4, i = rho & 15; return 8 * (i >> 2) + 4 * n + (i & 3); }

struct Unit { int pm, pn; };
struct Gemm { const bf16_t* A; const bf16_t* Bt; int M, N, K, lda, ldb; };

struct StaticOrder {
    int nM, nN, nwg, G, c;
    __host__ __device__ void init(int M, int N, int G_, int c_) { nM = M / BM; nN = N / BM; nwg = nM * nN; G = G_; c = c_; }
    __host__ __device__ bool next(int i, Unit& u) const {
        const long L = (long)i * G + c; if (L >= nwg) return false;
        int wgid = (int)L; { const int q = nwg / NXCD, r = nwg % NXCD, xcd = wgid % NXCD, off = wgid / NXCD; wgid = (xcd < r ? xcd * (q + 1) : r * (q + 1) + (xcd - r) * q) + off; }
        const int nig = WGM * nN, gid = wgid / nig, fm = gid * WGM, gsz = (nM - fm) < WGM ? (nM - fm) : WGM;
        u.pm = fm + ((wgid % nig) % gsz); u.pn = (wgid % nig) / gsz; return true;
    }
    __device__ __forceinline__ void a_ready(const Unit&) const {}
    __device__ __forceinline__ void done(const Unit&) const {}
};


__device__ __forceinline__ unsigned cvt_pk_bf16(float lo, float hi) { unsigned r; asm volatile("v_cvt_pk_bf16_f32 %0, %1, %2" : "=v"(r) : "v"(lo), "v"(hi)); return r; }
__device__ __forceinline__ u32x4 pack8(const f32x4 v0, const f32x4 v1) { u32x4 w; w.x = cvt_pk_bf16(v0[0], v0[1]); w.y = cvt_pk_bf16(v0[2], v0[3]); w.z = cvt_pk_bf16(v1[0], v1[1]); w.w = cvt_pk_bf16(v1[2], v1[3]); return w; }
__device__ __forceinline__ float gelu_tanh(float x) {
    const float t = x * (1.0f + 0.044715f * x * x) * (-2.0f * 0.7978845608028654f * 1.4426950408889634f);
    return x * __builtin_amdgcn_rcpf(1.0f + __builtin_amdgcn_exp2f(t));
}
__device__ __forceinline__ f32x4 gelu4(f32x4 v) { return (f32x4){gelu_tanh(v[0]), gelu_tanh(v[1]), gelu_tanh(v[2]), gelu_tanh(v[3])}; }
__device__ __forceinline__ float sumsq8(const f32x4 a, const f32x4 b) { return (a[0] * a[0] + a[1] * a[1]) + (a[2] * a[2] + a[3] * a[3]) + (b[0] * b[0] + b[1] * b[1]) + (b[2] * b[2] + b[3] * b[3]); }
__device__ __forceinline__ float sum4(const f32x4 a) { return (a[0] + a[1]) + (a[2] + a[3]); }
__device__ __forceinline__ float fq_sum(float s) { s += __shfl_xor(s, 16); s += __shfl_xor(s, 32); return s; }
__device__ __forceinline__ int row_pos(int row) { return row < 32768 ? (row & 4095) : (row & 2047); }
__device__ __forceinline__ void rope8(f32x4& v0, f32x4& v1, const float* ropec, const float* ropes, int pos, int i0) {
    const f32x4 c = *(const f32x4*)(ropec + pos * 32 + i0), s = *(const f32x4*)(ropes + pos * 32 + i0);
    const f32x4 a = v0, b = v1;
    v0[0] = a[0] * c[0] - a[1] * s[0]; v0[1] = a[0] * s[0] + a[1] * c[0];
    v0[2] = a[2] * c[1] - a[3] * s[1]; v0[3] = a[2] * s[1] + a[3] * c[1];
    v1[0] = b[0] * c[2] - b[1] * s[2]; v1[1] = b[0] * s[2] + b[1] * c[2];
    v1[2] = b[2] * c[3] - b[3] * s[3]; v1[3] = b[2] * s[3] + b[3] * c[3];
}

struct EpiZ {
    static constexpr bool PERM = true, AFTER_DRAIN = false;
    bf16_t* Z; bf16_t* KF; float* stat1; const float* ropec; const float* ropes;
    __device__ __forceinline__ void operator()(const f32x4 (&acc)[2][2][4][2], const Unit& u, int wr, int wc, int fr, int fq) const {
        asm volatile("" : "+v"(fr), "+v"(fq));
        const int row0 = u.pm * BM + wr * 64 + fr;
#pragma unroll
        for (int ai = 0; ai < 2; ++ai)
#pragma unroll
            for (int m = 0; m < 4; ++m) { const int row = row0 + ai * HALF + m * 16;
#pragma unroll
                for (int bj = 0; bj < 2; ++bj) { const int hidx = 2 * u.pn + bj; const int col8 = u.pn * BM + bj * HALF + wc * 32 + 8 * fq;
                    f32x4 v0 = acc[ai][bj][m][0], v1 = acc[ai][bj][m][1];
                    if (u.pn < 4) { v0 = gelu4(v0); v1 = gelu4(v1); *(u32x4*)(Z + (size_t)row * 1792 + col8) = pack8(v0, v1); }
                    else if (hidx <= 12) { *(u32x4*)(Z + (size_t)row * 1792 + col8) = pack8(v0, v1);
                        const float ss = fq_sum(sumsq8(v0, v1)); if (fq == 0) stat1[(size_t)row * 20 + (hidx - 8) * 4 + wc] = ss; }
                    else if (wc < 2) { rope8(v0, v1, ropec, ropes, row_pos(row), 16 * wc + 4 * fq); const u32x4 w = pack8(v0, v1);
                        bf16_t* kp = KF + (size_t)row * 768 + 128 + 32 * wc + 8 * fq;
#pragma unroll
                        for (int h = 0; h < 4; ++h) *(u32x4*)(kp + h * 192) = w; }
                } }
    }
};
struct EpiQ {
    static constexpr bool PERM = true, AFTER_DRAIN = false;
    bf16_t* Q; const float* stat1; const float* ropec; const float* ropes;
    __device__ __forceinline__ void operator()(const f32x4 (&acc)[2][2][4][2], const Unit& u, int wr, int wc, int fr, int fq) const {
        asm volatile("" : "+v"(fr), "+v"(fq));
        const int row0 = u.pm * BM + wr * 64 + fr; const float QS = 0.07216878364870322f * 1.4426950408889634f;
#pragma unroll
        for (int ai = 0; ai < 2; ++ai)
#pragma unroll
            for (int m = 0; m < 4; ++m) { const int row = row0 + ai * HALF + m * 16;
                float part = 0.f; if (fq < 3) part = sum4(*(const f32x4*)(stat1 + (size_t)row * 20 + 4 * fq));
                part = fq_sum(part); const float rs = __builtin_amdgcn_rsqf(part * (1.0f / 384.0f) + 1e-6f) * QS; const int pos = row_pos(row);
#pragma unroll
                for (int bj = 0; bj < 2; ++bj) { const int col8 = u.pn * BM + bj * HALF + wc * 32 + 8 * fq; const int d = col8 % 192;
                    f32x4 v0 = acc[ai][bj][m][0] * rs, v1 = acc[ai][bj][m][1] * rs;
                    { const bool pe = d >= 128; const int i0 = pe ? (d - 128) >> 1 : 0; f32x4 c = *(const f32x4*)(ropec + pos * 32 + i0), s = *(const f32x4*)(ropes + pos * 32 + i0);
                      if (!pe) { c = (f32x4){1.f, 1.f, 1.f, 1.f}; s = (f32x4){0.f, 0.f, 0.f, 0.f}; }
                      const f32x4 a = v0, b = v1;
                      v0[0] = a[0] * c[0] - a[1] * s[0]; v0[1] = a[0] * s[0] + a[1] * c[0]; v0[2] = a[2] * c[1] - a[3] * s[1]; v0[3] = a[2] * s[1] + a[3] * c[1];
                      v1[0] = b[0] * c[2] - b[1] * s[2]; v1[1] = b[0] * s[2] + b[1] * c[2]; v1[2] = b[2] * c[3] - b[3] * s[3]; v1[3] = b[2] * s[3] + b[3] * c[3]; }
                    *(u32x4*)(Q + (size_t)row * 768 + col8) = pack8(v0, v1); } }
    }
};
struct EpiKV {
    static constexpr bool PERM = true, AFTER_DRAIN = false;
    bf16_t* KF; bf16_t* VF; const float* stat1;
    __device__ __forceinline__ void operator()(const f32x4 (&acc)[2][2][4][2], const Unit& u, int wr, int wc, int fr, int fq) const {
        asm volatile("" : "+v"(fr), "+v"(fq));
        const int row0 = u.pm * BM + wr * 64 + fr;
#pragma unroll
        for (int ai = 0; ai < 2; ++ai)
#pragma unroll
            for (int m = 0; m < 4; ++m) { const int row = row0 + ai * HALF + m * 16;
                float part = 0.f; if (fq < 2) part = sum4(*(const f32x4*)(stat1 + (size_t)row * 20 + 12 + 4 * fq));
                part = fq_sum(part); const float rs = __builtin_amdgcn_rsqf(part * (1.0f / 256.0f) + 1e-6f);
#pragma unroll
                for (int bj = 0; bj < 2; ++bj) { const int cin = wc * 32 + 8 * fq;
                    const f32x4 v0 = acc[ai][bj][m][0] * rs, v1 = acc[ai][bj][m][1] * rs;
                    bf16_t* dst = (u.pn < 2) ? KF + (size_t)row * 768 + (2 * u.pn + bj) * 192 + cin : VF + (size_t)row * 512 + (2 * (u.pn - 2) + bj) * 128 + cin;
                    *(u32x4*)dst = pack8(v0, v1); } }
    }
};
struct EpiX1 {
    static constexpr bool PERM = true, AFTER_DRAIN = false;
    const float* xp; const float* xs; float* X1; bf16_t* XB; float* stat2;
    __device__ __forceinline__ void operator()(const f32x4 (&acc)[2][2][4][2], const Unit& u, int wr, int wc, int fr, int fq) const {
        asm volatile("" : "+v"(fr), "+v"(fq));
        const int row0 = u.pm * BM + wr * 64 + fr;
        const float* xb = (u.pm < 128) ? xp : xs; const size_t xsub = (u.pm < 128) ? 0 : (size_t)32768 * 1024;
#pragma unroll
        for (int ai = 0; ai < 2; ++ai)
#pragma unroll
            for (int m = 0; m < 4; ++m) { const int row = row0 + ai * HALF + m * 16; float ss = 0.f;
#pragma unroll
                for (int bj = 0; bj < 2; ++bj) { const size_t off = (size_t)row * 1024 + u.pn * BM + bj * HALF + wc * 32 + 8 * fq;
                    const f32x4 v0 = acc[ai][bj][m][0] + *(const f32x4*)(xb + (off - xsub)), v1 = acc[ai][bj][m][1] + *(const f32x4*)(xb + (off - xsub) + 4);
                    *(f32x4*)(X1 + off) = v0; *(f32x4*)(X1 + off + 4) = v1; *(u32x4*)(XB + off) = pack8(v0, v1); ss += sumsq8(v0, v1); }
                ss = fq_sum(ss); if (fq == 0) stat2[(size_t)row * 16 + u.pn * 4 + wc] = ss; }
    }
};
struct EpiF {
    static constexpr bool PERM = true, AFTER_DRAIN = false;
    bf16_t* F; const float* stat2;
    __device__ __forceinline__ void operator()(const f32x4 (&acc)[2][2][4][2], const Unit& u, int wr, int wc, int fr, int fq) const {
        asm volatile("" : "+v"(fr), "+v"(fq));
        const int row0 = u.pm * BM + wr * 64 + fr;
#pragma unroll
        for (int ai = 0; ai < 2; ++ai)
#pragma unroll
            for (int m = 0; m < 4; ++m) { const int row = row0 + ai * HALF + m * 16;
                const float part = fq_sum(sum4(*(const f32x4*)(stat2 + (size_t)row * 16 + 4 * fq))); const float rs = __builtin_amdgcn_rsqf(part * (1.0f / 1024.0f) + 1e-6f);
#pragma unroll
                for (int bj = 0; bj < 2; ++bj) { const size_t off = (size_t)row * 4096 + u.pn * BM + bj * HALF + wc * 32 + 8 * fq;
                    f32x4 v0 = acc[ai][bj][m][0] * rs, v1 = acc[ai][bj][m][1] * rs;
#pragma unroll
                    for (int e = 0; e < 4; ++e) { const float a = fmaxf(v0[e], 0.f), b = fmaxf(v1[e], 0.f); v0[e] = a * a; v1[e] = b * b; }
                    *(u32x4*)(F + off) = pack8(v0, v1); } }
    }
};
struct EpiX2 {
    static constexpr bool PERM = true, AFTER_DRAIN = false;
    float* X;
    __device__ __forceinline__ void operator()(const f32x4 (&acc)[2][2][4][2], const Unit& u, int wr, int wc, int fr, int fq) const {
        asm volatile("" : "+v"(fr), "+v"(fq));
        const int row0 = u.pm * BM + wr * 64 + fr;
#pragma unroll
        for (int ai = 0; ai < 2; ++ai)
#pragma unroll
            for (int m = 0; m < 4; ++m) { const int row = row0 + ai * HALF + m * 16;
#pragma unroll
                for (int bj = 0; bj < 2; ++bj) { const size_t off = (size_t)row * 1024 + u.pn * BM + bj * HALF + wc * 32 + 8 * fq;
                    const f32x4 v0 = acc[ai][bj][m][0] + *(const f32x4*)(X + off), v1 = acc[ai][bj][m][1] + *(const f32x4*)(X + off + 4);
                    *(f32x4*)(X + off) = v0; *(f32x4*)(X + off + 4) = v1; } }
    }
};
template <class Epi, class Sched, bool ALIGN_EPI = false, bool SP2 = false>
__device__ __forceinline__ void gemm_phase(PG8_LAS unsigned char* lds, const Gemm g, const Sched& S, const Epi& E) {
    int tid_ = threadIdx.x; asm volatile("" : "+v"(tid_));
    const int tid = tid_, wid = __builtin_amdgcn_readfirstlane(tid >> 6), lane = tid & 63, wr = wid >> 2, wc = wid & 3, fr = lane & 15, fq = lane >> 4;
    const int K = g.K, nt = K / BK;
    unsigned voffA[2], voffB[2];
#pragma unroll
    for (int i = 0; i < 2; ++i) { int R, C; stage_rc(tid * 16 + i * 8192, R, C); const int Rb = Epi::PERM ? ((R & ~31) + perm32(R & 31)) : R;
        voffA[i] = (unsigned)(R * g.lda + C) * 2u; voffB[i] = (unsigned)(Rb * g.ldb + C) * 2u; }
    const size_t kstep = (size_t)(BK * 2);
    const size_t hstepA = (size_t)HALF * g.lda * 2, hstepB = (size_t)HALF * g.ldb * 2;
    const size_t tstepA = 2 * hstepA, tstepB = 2 * hstepB;
    const unsigned ldsw = (unsigned)wid * 1024u;
    const int aoff = lds_byte(wr * 64 + fr, fq * 8), boff = lds_byte(wc * 32 + fr, fq * 8);
#define PG8_SA(b, h) (((b) * 2 + (h)) * HTB)
#define PG8_SB(b, h) ((4 + (b) * 2 + (h)) * HTB)
#define PG8_STAGE(bufoff, gbase, voff) do { _Pragma("unroll") for (int _i = 0; _i < 2; ++_i) \
        __builtin_amdgcn_global_load_lds((const unsigned*)((const char*)(gbase) + (voff)[_i]), (PG8_LAS unsigned*)(lds + (bufoff) + ldsw + _i * 8192), 16, 0, 0); } while (0)
#define PG8_LDA(dst, b, h) do { _Pragma("unroll") for (int m = 0; m < 4; ++m) _Pragma("unroll") for (int k = 0; k < 2; ++k) dst[m][k] = *(const PG8_LAS bf16x8*)(lds + PG8_SA(b, h) + aoff + m * 2048 + k * 1024); } while (0)
#define PG8_LDB(dst, b, h) do { _Pragma("unroll") for (int n = 0; n < 2; ++n) _Pragma("unroll") for (int k = 0; k < 2; ++k) dst[n][k] = *(const PG8_LAS bf16x8*)(lds + PG8_SB(b, h) + boff + n * 2048 + k * 1024); } while (0)
#define PG8_MMA(ai, bj, At, Bt) do { __builtin_amdgcn_s_setprio(1); _Pragma("unroll") for (int m = 0; m < 4; ++m) _Pragma("unroll") for (int n = 0; n < 2; ++n) _Pragma("unroll") for (int k = 0; k < 2; ++k) \
        acc[ai][bj][m][n] = __builtin_amdgcn_mfma_f32_16x16x32_bf16(Bt[n][k], At[m][k], acc[ai][bj][m][n], 0, 0, 0); __builtin_amdgcn_s_setprio(0); } while (0)
#define PG8_WAIT_V(n) asm volatile("s_waitcnt vmcnt(" #n ")" ::: "memory")
#define PG8_WAIT_L(n) asm volatile("s_waitcnt lgkmcnt(" #n ")" ::: "memory")
#define PG8_BAR __builtin_amdgcn_s_barrier()
#define PG8_SCHED __builtin_amdgcn_sched_barrier(0)
    Unit cur, nxt; int ui = 0;
    if (!S.next(0, cur)) return;
    f32x4 acc[2][2][4][2];
#pragma unroll
    for (int a = 0; a < 2; ++a)
#pragma unroll
        for (int b = 0; b < 2; ++b)
#pragma unroll
            for (int m = 0; m < 4; ++m)
#pragma unroll
                for (int n = 0; n < 2; ++n) acc[a][b][m][n] = (f32x4){0.f, 0.f, 0.f, 0.f};
    bf16x8 At[4][2], B0[2][2], B1[2][2];
    const char* cA = (const char*)g.A + (size_t)cur.pm * tstepA; const char* cB = (const char*)g.Bt + (size_t)cur.pn * tstepB;
    S.a_ready(cur);
    if constexpr (SP2) {
        PG8_STAGE(PG8_SB(0, 0), cB, voffB); PG8_STAGE(PG8_SB(0, 1), cB + hstepB, voffB); PG8_STAGE(PG8_SA(0, 0), cA, voffA); PG8_STAGE(PG8_SA(0, 1), cA + hstepA, voffA);
        if (wr == 1) PG8_BAR;
        PG8_WAIT_V(2); PG8_BAR;
        PG8_STAGE(PG8_SB(1, 0), cB + kstep, voffB); PG8_STAGE(PG8_SA(1, 0), cA + kstep, voffA); PG8_STAGE(PG8_SB(1, 1), cB + hstepB + kstep, voffB);
        PG8_WAIT_V(6); PG8_BAR;
    } else {
        PG8_STAGE(PG8_SB(0, 0), cB, voffB); PG8_STAGE(PG8_SA(0, 0), cA, voffA); PG8_STAGE(PG8_SB(0, 1), cB + hstepB, voffB); PG8_STAGE(PG8_SA(0, 1), cA + hstepA, voffA);
        if (wr == 1) PG8_BAR;
        PG8_WAIT_V(4); PG8_BAR;
        PG8_STAGE(PG8_SB(1, 0), cB + kstep, voffB); PG8_STAGE(PG8_SA(1, 0), cA + kstep, voffA); PG8_STAGE(PG8_SB(1, 1), cB + hstepB + kstep, voffB);
        PG8_WAIT_V(6); PG8_BAR;
    }
    for (;;) {
        const bool has_next = S.next(ui + 1, nxt);
        const char* nA = has_next ? (const char*)g.A + (size_t)nxt.pm * tstepA : cA; const char* nB = has_next ? (const char*)g.Bt + (size_t)nxt.pn * tstepB : cB;
#pragma unroll 1
        for (int t = 0; t < nt; t += 2) {
            const bool last = (t == nt - 2);
            const char* a1 = cA + (size_t)(t + 1) * kstep;
            const char* a2 = last ? nA : cA + (size_t)(t + 2) * kstep; const char* b2 = last ? nB : cB + (size_t)(t + 2) * kstep;
            const char* a3 = a2 + kstep; const char* b3 = b2 + kstep;
            if (last && has_next) S.a_ready(nxt);
            if constexpr (SP2) {
            PG8_LDB(B0, 0, 0); PG8_LDB(B1, 0, 1); PG8_SCHED; PG8_LDA(At, 0, 0); PG8_STAGE(PG8_SA(1, 1), a1 + hstepA, voffA);
            PG8_WAIT_V(8); PG8_WAIT_L(0); PG8_BAR; PG8_MMA(0, 0, At, B0); PG8_MMA(0, 1, At, B1); PG8_BAR; PG8_SCHED;
            PG8_LDA(At, 0, 1); PG8_STAGE(PG8_SB(0, 0), b2, voffB); PG8_STAGE(PG8_SB(0, 1), b2 + hstepB, voffB); PG8_STAGE(PG8_SA(0, 0), a2, voffA);
            PG8_WAIT_V(8); PG8_WAIT_L(0); PG8_BAR; PG8_MMA(1, 0, At, B0); PG8_MMA(1, 1, At, B1); PG8_BAR; PG8_SCHED;
            PG8_LDB(B0, 1, 0); PG8_LDB(B1, 1, 1); PG8_SCHED; PG8_LDA(At, 1, 0); PG8_STAGE(PG8_SA(0, 1), a2 + hstepA, voffA);
            PG8_WAIT_V(8); PG8_WAIT_L(0); PG8_BAR; PG8_MMA(0, 0, At, B0); PG8_MMA(0, 1, At, B1); PG8_BAR; PG8_SCHED;
            PG8_LDA(At, 1, 1); PG8_STAGE(PG8_SB(1, 0), b3, voffB); PG8_STAGE(PG8_SB(1, 1), b3 + hstepB, voffB); PG8_STAGE(PG8_SA(1, 0), a3, voffA);
            PG8_WAIT_V(8); PG8_WAIT_L(0); PG8_BAR; PG8_MMA(1, 0, At, B0); PG8_MMA(1, 1, At, B1); PG8_BAR; PG8_SCHED;
            } else {
            PG8_LDB(B0, 0, 0); PG8_SCHED; PG8_LDA(At, 0, 0); PG8_STAGE(PG8_SA(1, 1), a1 + hstepA, voffA);
            PG8_WAIT_L(8); PG8_BAR; PG8_WAIT_L(0); PG8_MMA(0, 0, At, B0); PG8_BAR; PG8_SCHED;
            PG8_LDB(B1, 0, 1); PG8_STAGE(PG8_SB(0, 0), b2, voffB);
            PG8_BAR; PG8_WAIT_L(0); PG8_MMA(0, 1, At, B1); PG8_BAR;
            PG8_LDA(At, 0, 1); PG8_STAGE(PG8_SA(0, 0), a2, voffA);
            PG8_BAR; PG8_WAIT_L(0); PG8_MMA(1, 0, At, B0); PG8_BAR; PG8_SCHED;
            PG8_STAGE(PG8_SB(0, 1), b2 + hstepB, voffB);
            PG8_WAIT_V(6); PG8_BAR; PG8_MMA(1, 1, At, B1); PG8_BAR;
            PG8_LDB(B0, 1, 0); PG8_SCHED; PG8_LDA(At, 1, 0); PG8_STAGE(PG8_SA(0, 1), a2 + hstepA, voffA);
            PG8_WAIT_L(8); PG8_BAR; PG8_WAIT_L(0); PG8_MMA(0, 0, At, B0); PG8_BAR; PG8_SCHED;
            PG8_LDB(B1, 1, 1); PG8_STAGE(PG8_SB(1, 0), b3, voffB);
            PG8_BAR; PG8_WAIT_L(0); PG8_MMA(0, 1, At, B1); PG8_BAR;
            PG8_LDA(At, 1, 1); PG8_STAGE(PG8_SA(1, 0), a3, voffA);
            PG8_BAR; PG8_WAIT_L(0); PG8_MMA(1, 0, At, B0); PG8_BAR; PG8_SCHED;
            PG8_STAGE(PG8_SB(1, 1), b3 + hstepB, voffB);
            PG8_WAIT_V(6); PG8_BAR; PG8_MMA(1, 1, At, B1); PG8_BAR;
            }
        }
        if constexpr (ALIGN_EPI) { if (wr == 0) PG8_BAR; }
        if constexpr (!Epi::AFTER_DRAIN) { E(acc, cur, wr, wc, fr, fq); S.done(cur); }
        if (!has_next) break;
#pragma unroll
        for (int a = 0; a < 2; ++a)
#pragma unroll
            for (int b = 0; b < 2; ++b)
#pragma unroll
                for (int m = 0; m < 4; ++m)
#pragma unroll
                    for (int n = 0; n < 2; ++n) acc[a][b][m][n] = (f32x4){0.f, 0.f, 0.f, 0.f};
        cur = nxt; cA = nA; cB = nB; ++ui;
        if constexpr (ALIGN_EPI) { if (wr == 1) PG8_BAR; }
    }
    PG8_WAIT_V(0);
    if constexpr (!ALIGN_EPI) { if (wr == 0) PG8_BAR; }
    PG8_BAR;
    if constexpr (Epi::AFTER_DRAIN) { E.fused(acc, cur, wr, wc, fr, fq, lds, wid, lane); S.done(cur); }
#undef PG8_SA
#undef PG8_SB
#undef PG8_STAGE
#undef PG8_LDA
#undef PG8_LDB
#undef PG8_MMA
#undef PG8_WAIT_V
#undef PG8_WAIT_L
#undef PG8_BAR
#undef PG8_SCHED
}
}

namespace att {
using bf16x8 = __attribute__((ext_vector_type(8))) short;
using s16x4  = __attribute__((ext_vector_type(4))) short;
using f32x16 = __attribute__((ext_vector_type(16))) float;
using u32x4  = __attribute__((ext_vector_type(4))) unsigned;
typedef unsigned short bf16_t;
constexpr int DQK = 192, DV = 128, NW = 8, QBLK = 32, KVBLK = 64;
constexpr int LDQ = 768, LDK = 768, LDV = 512, LDY = 1024;
constexpr float THR = 11.5f;
constexpr int KROW = 400;
constexpr int SHM_V = KVBLK * DV * 2, SHM_K = KVBLK * KROW;
constexpr int SHM_ATTN = 2 * SHM_V + 2 * SHM_K + NW * 96 * 4;
#define KSWZ(row, colB) ((row) * KROW + (colB))
#define SBAR() __builtin_amdgcn_sched_barrier(0)
__device__ __forceinline__ int crow(int r, int hi) { return (r & 3) + 8 * (r >> 2) + 4 * hi; }
__device__ __forceinline__ unsigned cvtpk(float lo, float hi) { unsigned r; asm volatile("v_cvt_pk_bf16_f32 %0, %1, %2" : "=v"(r) : "v"(lo), "v"(hi)); return r; }

__device__ __forceinline__ void partialSM(f32x16& p0, f32x16& p1, float& m_reg, float& mn, float& alpha) {
  float pmax = p0[0];
#pragma unroll
  for (int r = 1; r < 16; ++r) pmax = fmaxf(pmax, p0[r]);
#pragma unroll
  for (int r = 0; r < 16; ++r) pmax = fmaxf(pmax, p1[r]);
  { auto rr = __builtin_amdgcn_permlane32_swap(__float_as_uint(pmax), __float_as_uint(pmax), false, false);
    pmax = fmaxf(__uint_as_float(rr[0]), __uint_as_float(rr[1])); }
  if (__builtin_expect(__all(pmax - m_reg <= THR), 1)) { mn = m_reg; alpha = 1.f; }
  else { mn = fmaxf(m_reg, pmax); alpha = __builtin_amdgcn_exp2f(m_reg - mn); m_reg = mn; }
#pragma unroll
  for (int r = 0; r < 16; ++r) p0[r] = p0[r] - mn;
#pragma unroll
  for (int r = 0; r < 16; ++r) p1[r] = p1[r] - mn;
#pragma unroll
  for (int r = 0; r < 16; ++r) p0[r] = __builtin_amdgcn_exp2f(p0[r]);
}
__device__ __forceinline__ void finishSM(f32x16& p0, f32x16& p1, float alpha, float& l_reg, bf16x8& pa0, bf16x8& pa1, bf16x8& pa2, bf16x8& pa3) {
#pragma unroll
  for (int r = 0; r < 16; ++r) p1[r] = __builtin_amdgcn_exp2f(p1[r]);
  float ps = 0;
#pragma unroll
  for (int r = 0; r < 16; ++r) ps += p0[r];
#pragma unroll
  for (int r = 0; r < 16; ++r) ps += p1[r];
  { auto rr = __builtin_amdgcn_permlane32_swap(__float_as_uint(ps), __float_as_uint(ps), false, false);
    ps = __uint_as_float(rr[0]) + __uint_as_float(rr[1]); }
  l_reg = l_reg * alpha + ps;
#define PK4(P, BASE, OUT) do { unsigned a0 = cvtpk(P[BASE + 0], P[BASE + 1]), a1 = cvtpk(P[BASE + 2], P[BASE + 3]);   \
    unsigned b0 = cvtpk(P[BASE + 4], P[BASE + 5]), b1 = cvtpk(P[BASE + 6], P[BASE + 7]);                              \
    auto r0 = __builtin_amdgcn_permlane32_swap(a0, b0, false, false); auto r1 = __builtin_amdgcn_permlane32_swap(a1, b1, false, false); \
    u32x4 w = {r0[0], r1[0], r0[1], r1[1]}; OUT = *reinterpret_cast<bf16x8*>(&w); } while (0)
  PK4(p0, 0, pa0); PK4(p0, 8, pa1); PK4(p1, 0, pa2); PK4(p1, 8, pa3);
#undef PK4
}
__device__ __forceinline__ void qkt(f32x16& p0, f32x16& p1, const char* Ks, const bf16x8* qr, int r32, int hi) {
  p0 = f32x16{}; p1 = f32x16{};
  const char* kb = Ks + r32 * KROW + hi * 16;
#pragma unroll
  for (int d0 = 0; d0 < 12; ++d0) {
    bf16x8 b0 = *reinterpret_cast<const bf16x8*>(kb + d0 * 32);
    bf16x8 b1 = *reinterpret_cast<const bf16x8*>(kb + 32 * KROW + d0 * 32);
    p0 = __builtin_amdgcn_mfma_f32_32x32x16_bf16(b0, qr[d0], p0, 0, 0, 0);
    p1 = __builtin_amdgcn_mfma_f32_32x32x16_bf16(b1, qr[d0], p1, 0, 0, 0); }
}
__device__ __forceinline__ int v_st(int k, int c) { const int kk = (k & ~0xC) | ((k & 4) << 1) | ((k & 8) >> 1); return ((kk >> 3) * 4 + (c >> 5)) * 512 + ((kk & 7) * 32 + (c & 31)) * 2; }
__device__ __forceinline__ int v_rd_base(int lane) { return ((lane & 3) << 3) | (((lane >> 2) & 3) << 6) | (((lane >> 4) & 1) << 5) | (((lane >> 5) & 1) << 8); }
constexpr int v_rd_off(int d0, int ks, int half) { return d0 * 512 + ks * 4096 + half * 2048; }
template <int OFF> __device__ __forceinline__ s16x4 tr_read(int vb) {
  s16x4 r; asm volatile("ds_read_b64_tr_b16 %0, %1 offset:%2" : "=&v"(r) : "v"(vb), "i"(OFF) : "memory"); return r;
}
#define PKV(L, H) (bf16x8){L[0], L[1], L[2], L[3], H[0], H[1], H[2], H[3]}
template <int D0> __device__ __forceinline__ void pv_one(f32x16& od, int vb, bf16x8 pa0, bf16x8 pa1, bf16x8 pa2, bf16x8 pa3) {
  const s16x4 l0 = tr_read<v_rd_off(D0, 0, 0)>(vb), h0 = tr_read<v_rd_off(D0, 0, 1)>(vb), l1 = tr_read<v_rd_off(D0, 1, 0)>(vb), h1 = tr_read<v_rd_off(D0, 1, 1)>(vb);
  const s16x4 l2 = tr_read<v_rd_off(D0, 2, 0)>(vb), h2 = tr_read<v_rd_off(D0, 2, 1)>(vb), l3 = tr_read<v_rd_off(D0, 3, 0)>(vb), h3 = tr_read<v_rd_off(D0, 3, 1)>(vb);
  asm volatile("s_waitcnt lgkmcnt(0)" ::: "memory"); SBAR();
  od = __builtin_amdgcn_mfma_f32_32x32x16_bf16(pa0, PKV(l0, h0), od, 0, 0, 0);
  od = __builtin_amdgcn_mfma_f32_32x32x16_bf16(pa1, PKV(l1, h1), od, 0, 0, 0);
  od = __builtin_amdgcn_mfma_f32_32x32x16_bf16(pa2, PKV(l2, h2), od, 0, 0, 0);
  od = __builtin_amdgcn_mfma_f32_32x32x16_bf16(pa3, PKV(l3, h3), od, 0, 0, 0);
}
__device__ __forceinline__ void pv_d0(f32x16* o, int vb, bf16x8 pa0, bf16x8 pa1, bf16x8 pa2, bf16x8 pa3) {
  pv_one<0>(o[0], vb, pa0, pa1, pa2, pa3); pv_one<1>(o[1], vb, pa0, pa1, pa2, pa3); pv_one<2>(o[2], vb, pa0, pa1, pa2, pa3); pv_one<3>(o[3], vb, pa0, pa1, pa2, pa3);
}

__device__ __forceinline__ void attn_head(const bf16_t* __restrict__ Qb, const bf16_t* __restrict__ Kh, const bf16_t* __restrict__ Vh, bf16_t* Yb, int seq, char* lds) {
  int tid_ = threadIdx.x; asm volatile("" : "+v"(tid_));
  const int tid = tid_, wid = __builtin_amdgcn_readfirstlane(tid >> 6), lane = tid & 63, r32 = lane & 31, hi = lane >> 5;
  char* V_lds = lds; char* K_lds = lds + 2 * SHM_V;
  float* ws = (float*)(lds + 2 * SHM_V + 2 * SHM_K) + wid * 96; float* li_l = ws; float* al_l = ws + 32;
  float m_reg = -1e30f, l_reg = 0; f32x16 o[4] = {}; bf16x8 qr[12];
  const bf16_t* Qw = Qb + (long)(wid * QBLK + r32) * LDQ + hi * 8;
#pragma unroll
  for (int d0 = 0; d0 < 12; ++d0) qr[d0] = *reinterpret_cast<const bf16x8*>(Qw + d0 * 16);
  const int sr = tid >> 4, sc = (tid & 15) * 8, vst0 = v_st(sr, sc), vst1 = v_st(32 + sr, sc);
  int kgo[3], klo[3];
#pragma unroll
  for (int i = 0; i < 3; ++i) { const int idx = tid + 512 * i, row = idx / 24, g = idx % 24; kgo[i] = row * LDK + g * 8; klo[i] = KSWZ(row, g * 16); }
  const int vb0 = (int)(uintptr_t)V_lds + v_rd_base(lane);
  struct { bf16x8 vs0, vs1, ks0, ks1, ks2; } sr_[1];
#define SLOAD(i, k0) do { sr_[i].vs0 = *reinterpret_cast<const bf16x8*>(&Vh[(long)((k0) + sr) * LDV + sc]); sr_[i].vs1 = *reinterpret_cast<const bf16x8*>(&Vh[(long)((k0) + 32 + sr) * LDV + sc]); \
    sr_[i].ks0 = *reinterpret_cast<const bf16x8*>(&Kh[(long)(k0) * LDK + kgo[0]]); sr_[i].ks1 = *reinterpret_cast<const bf16x8*>(&Kh[(long)(k0) * LDK + kgo[1]]); \
    sr_[i].ks2 = *reinterpret_cast<const bf16x8*>(&Kh[(long)(k0) * LDK + kgo[2]]); } while (0)
#define SWRITE(b, i) do { *(bf16x8*)(V_lds + (b) * SHM_V + vst0) = sr_[i].vs0; *(bf16x8*)(V_lds + (b) * SHM_V + vst1) = sr_[i].vs1; \
    *(bf16x8*)(K_lds + (b) * SHM_K + klo[0]) = sr_[i].ks0; *(bf16x8*)(K_lds + (b) * SHM_K + klo[1]) = sr_[i].ks1; *(bf16x8*)(K_lds + (b) * SHM_K + klo[2]) = sr_[i].ks2; } while (0)
#define SWAIT() asm volatile("s_waitcnt vmcnt(0)" ::: "memory")
#define RESC(a) do { if (__any((a) < 1.f)) { if (hi == 0) al_l[r32] = (a); asm volatile("s_waitcnt lgkmcnt(0)" ::: "memory"); \
    _Pragma("unroll") for (int d = 0; d < 4; ++d) _Pragma("unroll") for (int r = 0; r < 16; ++r) o[d][r] *= al_l[crow(r, hi)]; } } while (0)
  f32x16 pA0, pA1, pB0, pB1; float mnA, mnB, alA, alB; bf16x8 pa0, pa1, pa2, pa3; const int NT = seq / KVBLK;
  constexpr int SE = 0, SO = 0;
  SLOAD(SE, 0); asm volatile("s_waitcnt vmcnt(0)" ::: "memory"); SWRITE(0, SE); __syncthreads();
  qkt(pA0, pA1, K_lds, qr, r32, hi); partialSM(pA0, pA1, m_reg, mnA, alA);
  SLOAD(SO, KVBLK);
  SWAIT(); SWRITE(1, SO); __syncthreads();
  for (int j = 1; j + 1 < NT; j += 2) {
    SBAR(); qkt(pB0, pB1, K_lds + SHM_K, qr, r32, hi);
    finishSM(pA0, pA1, alA, l_reg, pa0, pa1, pa2, pa3); SBAR();
    SLOAD(SE, (j + 1) * KVBLK); SBAR();
    pv_d0(o, vb0, pa0, pa1, pa2, pa3); partialSM(pB0, pB1, m_reg, mnB, alB);
    __syncthreads(); SWAIT(); SWRITE(0, SE);
    RESC(alB); __syncthreads();
    SBAR(); qkt(pA0, pA1, K_lds, qr, r32, hi);
    finishSM(pB0, pB1, alB, l_reg, pa0, pa1, pa2, pa3); SBAR();
    SLOAD(SO, (j + 2) * KVBLK); SBAR();
    pv_d0(o, vb0 + SHM_V, pa0, pa1, pa2, pa3); partialSM(pA0, pA1, m_reg, mnA, alA);
    __syncthreads(); SWAIT(); SWRITE(1, SO);
    RESC(alA); __syncthreads();
  }
  SBAR(); qkt(pB0, pB1, K_lds + SHM_K, qr, r32, hi);
  finishSM(pA0, pA1, alA, l_reg, pa0, pa1, pa2, pa3); SBAR();
  pv_d0(o, vb0, pa0, pa1, pa2, pa3); partialSM(pB0, pB1, m_reg, mnB, alB);
  __syncthreads(); RESC(alB);
  finishSM(pB0, pB1, alB, l_reg, pa0, pa1, pa2, pa3); SBAR();
  pv_d0(o, vb0 + SHM_V, pa0, pa1, pa2, pa3);
  if (hi == 0) li_l[r32] = l_reg; asm volatile("s_waitcnt lgkmcnt(0)" ::: "memory");
  bf16_t* stg = (bf16_t*)(lds + SHM_ATTN) + wid * 4096;
#pragma unroll
  for (int r = 0; r < 16; ++r) { const int orow = crow(r, hi); const float rl = __builtin_amdgcn_rcpf(li_l[orow]);
#pragma unroll
    for (int d0 = 0; d0 < 4; ++d0) stg[orow * 128 + d0 * 32 + r32] = (bf16_t)(cvtpk(o[d0][r] * rl, 0.f) & 0xffffu); }
  asm volatile("s_waitcnt lgkmcnt(0)" ::: "memory");
  int le = threadIdx.x & 63; asm volatile("" : "+v"(le));
  bf16_t* Yw = Yb + (long)(wid * QBLK + (le >> 4)) * LDY + (le & 15) * 8; float* sq_l = ws + 64;
#pragma unroll
  for (int i = 0; i < 8; ++i) { const u32x4 v = *(const u32x4*)(stg + (i * 4 + (le >> 4)) * 128 + (le & 15) * 8); float s = 0.f;
#pragma unroll
    for (int e = 0; e < 4; ++e) { const float a = __uint_as_float(v[e] << 16), b = __uint_as_float(v[e] & 0xffff0000u); s += a * a + b * b; }
    s += __shfl_xor(s, 1); s += __shfl_xor(s, 2); s += __shfl_xor(s, 4); s += __shfl_xor(s, 8);
    if ((le & 15) == 0) sq_l[i * 4 + (le >> 4)] += s;
    *(u32x4*)(Yw + (long)(i * 4) * LDY) = v; }
  __syncthreads();
#undef SLOAD
#undef SWRITE
#undef SWAIT
#undef RESC
}
__device__ __forceinline__ void attn_unit(const bf16_t* Q, const bf16_t* KF, const bf16_t* VF, bf16_t* Y, const float* gb, int rowbase, int q0, int seq, char* lds) {
  int tid_ = threadIdx.x; asm volatile("" : "+v"(tid_));
  const int tid = tid_, wid = __builtin_amdgcn_readfirstlane(tid >> 6); int lane = tid & 63;
  float* sq_l = (float*)(lds + 2 * SHM_V + 2 * SHM_K) + wid * 96 + 64;
  if (lane < 32) sq_l[lane] = 0.f;
#pragma unroll 1
  for (int h = 0; h < 4; ++h)
    attn_head(Q + (long)(rowbase + q0) * LDQ + h * DQK, KF + (long)rowbase * LDK + h * DQK, VF + (long)rowbase * LDV + h * DV, Y + (long)(rowbase + q0) * LDY + 512 + h * DV, seq, lds);
  asm volatile("" : "+v"(lane));
  float ssq[8];
#pragma unroll
  for (int i = 0; i < 8; ++i) ssq[i] = __builtin_amdgcn_rsqf(sq_l[i * 4 + (lane >> 4)] * (1.0f / 512.0f) + 1e-6f);
  bf16_t* Yw = Y + (long)(rowbase + q0 + wid * QBLK + (lane >> 4)) * LDY + 512 + (lane & 15) * 8;
#pragma unroll 1
  for (int h = 0; h < 4; ++h) { const float* gp = gb + h * 128 + (lane & 15) * 8; const pg8::f32x4 g0 = *(const pg8::f32x4*)gp, g1 = *(const pg8::f32x4*)(gp + 4);
#pragma unroll
    for (int i = 0; i < 8; ++i) { bf16_t* p = Yw + (long)(i * 4) * LDY + h * 128; const u32x4 v = *(const u32x4*)p; const float rs = ssq[i]; u32x4 w;
      w.x = cvtpk(__uint_as_float(v.x << 16) * rs * g0[0], __uint_as_float(v.x & 0xffff0000u) * rs * g0[1]); w.y = cvtpk(__uint_as_float(v.y << 16) * rs * g0[2], __uint_as_float(v.y & 0xffff0000u) * rs * g0[3]);
      w.z = cvtpk(__uint_as_float(v.z << 16) * rs * g1[0], __uint_as_float(v.z & 0xffff0000u) * rs * g1[1]); w.w = cvtpk(__uint_as_float(v.w << 16) * rs * g1[2], __uint_as_float(v.w & 0xffff0000u) * rs * g1[3]);
      *(u32x4*)p = w; } }
}
#undef KSWZ
#undef SBAR
#undef PKV
}

namespace sgu {
using att::bf16x8; using att::s16x4; using att::f32x16; using att::bf16_t;
typedef unsigned u32x2 __attribute__((ext_vector_type(2)));
__device__ __forceinline__ float bf2f(unsigned short b) { return __uint_as_float((unsigned)b << 16); }
#define SG_PK(L, H) (bf16x8){L[0], L[1], L[2], L[3], H[0], H[1], H[2], H[3]}
template <int KS, int J> __device__ __forceinline__ bf16x8 vfrag(int vbh) {
  const s16x4 l = att::tr_read<(KS >> 2) * 16384 + J * 512 + (KS & 3) * 4096>(vbh), h = att::tr_read<(KS >> 2) * 16384 + J * 512 + (KS & 3) * 4096 + 2048>(vbh);
  asm volatile("s_waitcnt lgkmcnt(0)" ::: "memory"); return SG_PK(l, h);
}
__device__ __forceinline__ void sgu_unit(const bf16_t* __restrict__ Z, const bf16_t* __restrict__ Ws, const float* __restrict__ bsp, const float* __restrict__ gsgu, const float* __restrict__ ga,
                                         bf16_t* __restrict__ Y, int chunk, char* lds) {
  int tid_ = threadIdx.x; asm volatile("" : "+v"(tid_));
  const int tid = tid_, wid = __builtin_amdgcn_readfirstlane(tid >> 6), lane = tid & 63, r32 = lane & 31, hi = lane >> 5;
  const long row0 = (long)chunk * 128;
#pragma unroll 1
  for (int it = 0; it < 4; ++it) {
    bf16x8 raw[4];
#pragma unroll
    for (int i = 0; i < 4; ++i) { const int idx = tid + 512 * (it * 4 + i), row = idx >> 6, g = idx & 63; raw[i] = *reinterpret_cast<const bf16x8*>(Z + (row0 + row) * 1792 + 512 + g * 8); }
#pragma unroll
    for (int i = 0; i < 4; ++i) { const int idx = tid + 512 * (it * 4 + i), row = idx >> 6, g = idx & 63;
      float f[8]; float ss = 0.f;
#pragma unroll
      for (int e = 0; e < 8; ++e) { f[e] = bf2f((unsigned short)raw[i][e]); ss += f[e] * f[e]; }
      ss += __shfl_xor(ss, 1); ss += __shfl_xor(ss, 2); ss += __shfl_xor(ss, 4); ss += __shfl_xor(ss, 8);
      const float rs = __builtin_amdgcn_rsqf(ss * (1.0f / 128.0f) + 1e-6f);
      const pg8::f32x4 g0 = *(const pg8::f32x4*)(gsgu + g * 8), g1 = *(const pg8::f32x4*)(gsgu + g * 8 + 4);
      pg8::f32x4 a = {f[0] * rs * g0[0], f[1] * rs * g0[1], f[2] * rs * g0[2], f[3] * rs * g0[3]}, b = {f[4] * rs * g1[0], f[5] * rs * g1[1], f[6] * rs * g1[2], f[7] * rs * g1[3]};
      const pg8::u32x4 w = pg8::pack8(a, b);
      *(pg8::u32x4*)(lds + ((g >> 4) * 2 + (row >> 6)) * 16384 + att::v_st(row & 63, (g & 15) * 8)) = w; }
  }
  __syncthreads();
  const int pb = wid >> 1, dsel = wid & 1;
  const int vb = (int)(uintptr_t)lds + att::v_rd_base(lane) + dsel * 1024;
  const long row = row0 + 32 * pb + r32;
  float yreg[4][2][16]; float ssq = 0.f;
#pragma unroll
  for (int h = 0; h < 4; ++h) {
    f32x16 acc0 = {}, acc1 = {};
    const bf16_t* wp = Ws + (long)(h * 128 + 32 * pb + r32) * 128 + 8 * hi;
    const int vbh = vb + h * 32768;
#define SG_STEP(KS) do { const bf16x8 wf = *reinterpret_cast<const bf16x8*>(wp + 16 * KS); const bf16x8 v0 = vfrag<KS, 0>(vbh), v1 = vfrag<KS, 1>(vbh); \
      acc0 = __builtin_amdgcn_mfma_f32_32x32x16_bf16(v0, wf, acc0, 0, 0, 0); acc1 = __builtin_amdgcn_mfma_f32_32x32x16_bf16(v1, wf, acc1, 0, 0, 0); } while (0)
    SG_STEP(0); SG_STEP(1); SG_STEP(2); SG_STEP(3); SG_STEP(4); SG_STEP(5); SG_STEP(6); SG_STEP(7);
#undef SG_STEP
    const float bb = bsp[h * 128 + 32 * pb + r32];
#pragma unroll
    for (int j = 0; j < 2; ++j)
#pragma unroll
      for (int rq = 0; rq < 4; ++rq) { const int d = 32 * (2 * dsel + j) + 8 * rq + 4 * hi;
        const u32x2 uu = *reinterpret_cast<const u32x2*>(Z + row * 1792 + h * 128 + d);
        const float u0 = __uint_as_float(uu.x << 16), u1 = __uint_as_float(uu.x & 0xffff0000u), u2 = __uint_as_float(uu.y << 16), u3 = __uint_as_float(uu.y & 0xffff0000u);
        const f32x16& ac = j ? acc1 : acc0;
        const float y0 = (ac[4 * rq + 0] + bb) * u0, y1 = (ac[4 * rq + 1] + bb) * u1, y2 = (ac[4 * rq + 2] + bb) * u2, y3 = (ac[4 * rq + 3] + bb) * u3;
        yreg[h][j][4 * rq + 0] = y0; yreg[h][j][4 * rq + 1] = y1; yreg[h][j][4 * rq + 2] = y2; yreg[h][j][4 * rq + 3] = y3;
        ssq += (y0 * y0 + y1 * y1) + (y2 * y2 + y3 * y3); }
  }
  ssq += __shfl_xor(ssq, 32);
  float* xs = (float*)(lds + 131072);
  if (hi == 0) xs[wid * 32 + r32] = ssq;
  __syncthreads();
  const float tot = xs[wid * 32 + r32] + xs[(wid ^ 1) * 32 + r32];
  const float rs = __builtin_amdgcn_rsqf(tot * (1.0f / 512.0f) + 1e-6f);
#pragma unroll
  for (int h = 0; h < 4; ++h)
#pragma unroll
    for (int j = 0; j < 2; ++j)
#pragma unroll
      for (int rq = 0; rq < 4; ++rq) { const int c = h * 128 + 32 * (2 * dsel + j) + 8 * rq + 4 * hi; const pg8::f32x4 gg = *(const pg8::f32x4*)(ga + c);
        u32x2 w; w.x = pg8::cvt_pk_bf16(yreg[h][j][4 * rq + 0] * rs * gg[0], yreg[h][j][4 * rq + 1] * rs * gg[1]); w.y = pg8::cvt_pk_bf16(yreg[h][j][4 * rq + 2] * rs * gg[2], yreg[h][j][4 * rq + 3] * rs * gg[3]);
        *reinterpret_cast<u32x2*>(Y + row * 1024 + c) = w; }
  __syncthreads();
}
#undef SG_PK
}

typedef unsigned short bf16;
typedef float f32x4 __attribute__((ext_vector_type(4)));
typedef unsigned v4u __attribute__((ext_vector_type(4)));
#define LAS __attribute__((address_space(3)))
constexpr int M_P = 8 * 4096, M_S = 32 * 2048, M = M_P + M_S;
constexpr int DM = 1024, NZ = 1792, FF = 4096;
constexpr size_t MiB = 1u << 20;
constexpr size_t WS_WIN = 1 * MiB, WS_WUQ = 5 * MiB, WS_WUKV = 6 * MiB, WS_WOUT = 7 * MiB, WS_W1 = 9 * MiB, WS_W2 = 17 * MiB, WS_WS = 25 * MiB, WS_ROPEC = 26 * MiB, WS_ROPES = 27 * MiB;
constexpr size_t WS_ST1 = 28 * MiB, WS_ST2 = 36 * MiB;
constexpr size_t WS_XN = 48 * MiB;
constexpr size_t WS_Z = 240 * MiB, WS_KF = 576 * MiB, WS_VF = 720 * MiB, WS_Y = 816 * MiB;
constexpr size_t WS_F = 240 * MiB, WS_END = 1008 * MiB;
constexpr int LDS_BYTES = att::SHM_ATTN + 65536 > 131072 + 4096 ? att::SHM_ATTN + 65536 : 131072 + 4096;
constexpr int NWAVES = 8;
constexpr int LDS_CTL_OFF = LDS_BYTES, LDS_TOTAL = LDS_BYTES + 64;
constexpr size_t WS_BAR = 0, BAR_ZERO_BYTES = 16384;

__device__ __forceinline__ unsigned f2bf(float f) { unsigned u = __builtin_bit_cast(unsigned, f); return (u + 0x7fffu + ((u >> 16) & 1u)) >> 16; }
__device__ __forceinline__ unsigned pk2(float lo, float hi) { return f2bf(lo) | (f2bf(hi) << 16); }
__device__ __forceinline__ float wave_sum(float v) {
#pragma unroll
    for (int o = 1; o < 64; o <<= 1) v += __shfl_xor(v, o);
    return v;
}
__device__ __forceinline__ int colmap(int mode, int nd) {
    if (mode == 1) { if (nd < 1664) return nd; if (nd < 1728) { const int j = nd - 1664; return 1664 + (j & 1) * 32 + (j >> 1); } return -1; }
    if (mode == 2) { const int h = nd / 192, d = nd % 192; if (d < 128) return nd; const int j = d - 128; return h * 192 + 128 + (j & 1) * 32 + (j >> 1); }
    if (mode == 3) { const int t = nd >> 9, hh = (nd >> 7) & 3, d = nd & 127; return hh * 256 + t * 128 + d; }
    return nd;
}
__device__ __forceinline__ void transpose_item(const float* W, int K, int N, int Npad, bf16* WT, const float* gain, int mode, LAS float* scr, int item, int lane) {
    const int nblk = Npad / 32, kb = item / nblk, nb = item % nblk, k0 = 64 * kb, n0 = 32 * nb;
    const int src = colmap(mode, n0 + (lane & 31));
#pragma unroll 8
    for (int i = 0; i < 32; ++i) { const int kk = 2 * i + (lane >> 5); float v = 0.f; if (src >= 0) { v = W[(size_t)(k0 + kk) * N + src]; if (gain) v *= gain[k0 + kk]; } scr[kk * 33 + (lane & 31)] = v; }
    asm volatile("s_waitcnt lgkmcnt(0)" ::: "memory");
    const int c = lane & 7;
#pragma unroll
    for (int j = 0; j < 4; ++j) { const int n = (lane >> 3) + 8 * j; const LAS float* s = scr + (8 * c) * 33 + n;
        v4u o; o.x = pk2(s[0 * 33], s[1 * 33]); o.y = pk2(s[2 * 33], s[3 * 33]); o.z = pk2(s[4 * 33], s[5 * 33]); o.w = pk2(s[6 * 33], s[7 * 33]);
        *(v4u*)(WT + (size_t)(n0 + n) * K + k0 + 8 * c) = o; }
    asm volatile("s_waitcnt lgkmcnt(0)" ::: "memory");
}
typedef __attribute__((address_space(1))) unsigned gu32;
#define XB_TMO      128
#define XB_XCNT(j)  (256  + 64 * (j))
#define XB_XSUB(j)  (1280 + 64 * (j))
#define XB_XGEN(j)  (2304 + 64 * (j))
#define XB_TOP      3328
#define XB_TOPGEN   3392
#define XCD_BAR_WORDS 3456
#define XB_SPIN_CAP (1u << 18)

__device__ __forceinline__ unsigned xb_ld(unsigned* p)              { return __hip_atomic_load(p, __ATOMIC_RELAXED, __HIP_MEMORY_SCOPE_AGENT); }
__device__ __forceinline__ unsigned xb_add(unsigned* p, unsigned v) { return __hip_atomic_fetch_add(p, v, __ATOMIC_RELAXED, __HIP_MEMORY_SCOPE_AGENT); }
__device__ __forceinline__ unsigned xb_xcc_id() { return (unsigned)__builtin_amdgcn_s_getreg((3 << 11) | 20) & 0xFu; }
#define XB_SPIN(cond, bar) do { unsigned _sp = 0; while (cond) { __builtin_amdgcn_s_sleep(1); \
    if ((++_sp & 255u) == 0u) { if (xb_ld(&(bar)[XB_TMO])) break; if (_sp > XB_SPIN_CAP) { atomicAdd(&(bar)[XB_TMO], 1u); break; } } } } while (0)

struct XcdBarrier {
    unsigned* bar; unsigned x;
    volatile LAS unsigned* st;
};

__device__ __forceinline__ XcdBarrier xcd_barrier_post(unsigned* bar, volatile LAS unsigned* st) {
    XcdBarrier b; b.bar = bar; b.x = xb_xcc_id(); b.st = st;
    if (threadIdx.x == 0) (void)xb_add(&bar[XB_XCNT(b.x)], 1u);
    return b;
}
__device__ __forceinline__ void xcd_barrier_complete(unsigned* bar, unsigned x, unsigned& nloc, unsigned& nx) {
    const unsigned G = gridDim.x * gridDim.y * gridDim.z;
    unsigned sum, cnt, mine, sp = 0u;
    for (;;) {
        sum = 0u; cnt = 0u; mine = 0u;
#pragma unroll
        for (unsigned j = 0; j < 16; ++j) { const unsigned c = xb_ld(&bar[XB_XCNT(j)]); sum += c; cnt += (c > 0u) ? 1u : 0u; mine = (j == x) ? c : mine; }
        if (sum == G) break;
        __builtin_amdgcn_s_sleep(1);
        if ((++sp & 255u) == 0u) { if (xb_ld(&bar[XB_TMO])) break; if (sp > XB_SPIN_CAP) { atomicAdd(&bar[XB_TMO], 1u); break; } }
    }
    nloc = mine > 0u ? mine : 1u; nx = cnt > 0u ? cnt : 1u;
}

__device__ __forceinline__ void xcd_barrier(const XcdBarrier& b) {
    asm volatile("s_waitcnt vmcnt(0)" ::: "memory");
    __syncthreads();
    if (threadIdx.x == 0) {
        unsigned* bar = b.bar;
        __builtin_amdgcn_s_waitcnt(0);
        unsigned nloc = b.st[0], nx = b.st[1];
        if (nloc == 0u) { xcd_barrier_complete(bar, b.x, nloc, nx); b.st[0] = nloc; b.st[1] = nx; }
        const unsigned old = xb_add(&bar[XB_XSUB(b.x)], 1u);
        const unsigned gen = old / nloc;
        if (old + 1u == (gen + 1u) * nloc) {
            __builtin_amdgcn_fence(__ATOMIC_RELEASE, "agent");
            asm volatile("s_waitcnt vmcnt(0)" ::: "memory");
            const unsigned og = xb_add(&bar[XB_TOP], 1u);
            const unsigned tg = og / nx;
            if (og + 1u == (tg + 1u) * nx) xb_add(&bar[XB_TOPGEN], 1u);
            else XB_SPIN(xb_ld(&bar[XB_TOPGEN]) == tg, bar);
            __builtin_amdgcn_fence(__ATOMIC_ACQUIRE, "agent");
            xb_add(&bar[XB_XGEN(b.x)], 1u);
            asm volatile("s_waitcnt vmcnt(0)" ::: "memory");
        } else {
            XB_SPIN(xb_ld(&bar[XB_XGEN(b.x)]) == gen, bar);
            __builtin_amdgcn_fence(__ATOMIC_ACQUIRE, "agent");
            asm volatile("s_waitcnt vmcnt(0)" ::: "memory");
        }
    }
    __syncthreads();
}

struct Params { const float* in[18]; float* out; unsigned char* ws; int ph_lo, ph_hi; };
enum { I_XP = 0, I_XS, I_NMIX, I_WIN, I_SGUN, I_WSP, I_BSP, I_QN, I_WUQ, I_KVN, I_WUKV, I_ONA, I_ONB, I_WOUT, I_NFFN, I_W1, I_W2, I_NFIN };

__global__ void __launch_bounds__(NWAVES * 64, 2) mega_fwd(Params p) {
    extern __shared__ __attribute__((aligned(16))) unsigned char lds[];
    namespace cg = cooperative_groups;
    const int tid = threadIdx.x, lane = tid & 63, wave = __builtin_amdgcn_readfirstlane(tid >> 6);
    const int G = gridDim.x, bx = blockIdx.x;
    const int vcu = (G % 8 == 0) ? (bx % 8) * (G / 8) + bx / 8 : bx;
    unsigned char* ws = p.ws;
    bf16* Win_t = (bf16*)(ws + WS_WIN); bf16* Wuq_t = (bf16*)(ws + WS_WUQ); bf16* Wukv_t = (bf16*)(ws + WS_WUKV); bf16* Wout_t = (bf16*)(ws + WS_WOUT);
    bf16* W1_t = (bf16*)(ws + WS_W1); bf16* W2_t = (bf16*)(ws + WS_W2); bf16* Wsb = (bf16*)(ws + WS_WS);
    float* ropec = (float*)(ws + WS_ROPEC); float* ropes = (float*)(ws + WS_ROPES); float* stat1 = (float*)(ws + WS_ST1); float* stat2 = (float*)(ws + WS_ST2);
    bf16* XN = (bf16*)(ws + WS_XN); bf16* Qb = XN; bf16* XB = XN;
    bf16* Z = (bf16*)(ws + WS_Z); bf16* KF = (bf16*)(ws + WS_KF); bf16* VF = (bf16*)(ws + WS_VF); bf16* Y = (bf16*)(ws + WS_Y); bf16* Fb = (bf16*)(ws + WS_F);
    const int lo = p.ph_lo, hi_ = p.ph_hi;
    volatile LAS unsigned* bst = (volatile LAS unsigned*)((LAS unsigned char*)lds + LDS_CTL_OFF);
    if (tid < 16) bst[tid] = 0u;
    __syncthreads();
    XcdBarrier bar; bar.bar = (unsigned*)(ws + WS_BAR); bar.x = 0; bar.st = bst;
    if (hi_ - lo > 1) bar = xcd_barrier_post((unsigned*)(ws + WS_BAR), bst);
#ifndef PHMASK
#define PHMASK 0xFF
#endif
#define IN(k) ((((PHMASK) >> (k)) & 1) && lo <= (k) && (k) < hi_)
#define SEAM(k) do { if (IN(k) && IN((k) + 1)) { if ((k) == 0) cg::this_grid().sync(); else xcd_barrier(bar); } } while (0)
    const int gw = vcu * NWAVES + wave, NGW = G * NWAVES;

    if (IN(0)) {
        LAS float* scr = (LAS float*)((LAS unsigned char*)lds + wave * 16384);
        constexpr int I_A = 16 * 56, I_B = 6 * 24, I_C = 4 * 32, I_D = 16 * 32, I_E = 16 * 128, I_F = 64 * 32;
        for (int it = gw; it < I_A + I_B + I_C + I_D + I_E + I_F; it += NGW) {
            int r = it;
            if (r < I_A) { transpose_item(p.in[I_WIN], 1024, 1728, 1792, Win_t, p.in[I_NMIX], 1, scr, r, lane); continue; } r -= I_A;
            if (r < I_B) { transpose_item(p.in[I_WUQ], 384, 768, 768, Wuq_t, p.in[I_QN], 2, scr, r, lane); continue; } r -= I_B;
            if (r < I_C) { transpose_item(p.in[I_WUKV], 256, 1024, 1024, Wukv_t, p.in[I_KVN], 3, scr, r, lane); continue; } r -= I_C;
            if (r < I_D) { transpose_item(p.in[I_WOUT], 1024, 1024, 1024, Wout_t, nullptr, 0, scr, r, lane); continue; } r -= I_D;
            if (r < I_E) { transpose_item(p.in[I_W1], 1024, 4096, 4096, W1_t, p.in[I_NFFN], 0, scr, r, lane); continue; } r -= I_E;
            transpose_item(p.in[I_W2], 4096, 1024, 1024, W2_t, nullptr, 0, scr, r, lane);
        }
        for (int i = bx * 512 + tid; i < 4 * 128 * 128 / 2; i += G * 512) { const float a = p.in[I_WSP][2 * i], b = p.in[I_WSP][2 * i + 1]; ((unsigned*)Wsb)[i] = pk2(a, b); }
        for (int i = bx * 512 + tid; i < 4096 * 32; i += G * 512) { const int pos = i >> 5, k = i & 31;
            const float inv = __builtin_amdgcn_exp2f(-(float)k * 0.41524101186092029f); const float ang = (float)pos * inv;
            const double t = (double)ang * 0.15915494309189535; const float fr = (float)(t - __builtin_floor(t));
            ropec[i] = __builtin_amdgcn_cosf(fr); ropes[i] = __builtin_amdgcn_sinf(fr); }
        for (int m = gw; m < M; m += NGW) {
            const float* xrow = (m < M_P) ? p.in[I_XP] + (size_t)m * DM : p.in[I_XS] + (size_t)(m - M_P) * DM;
            const f32x4* xr = (const f32x4*)xrow + lane; f32x4 v[4]; float s = 0.f;
#pragma unroll
            for (int j = 0; j < 4; ++j) { v[j] = xr[64 * j]; s += (v[j].x * v[j].x + v[j].y * v[j].y) + (v[j].z * v[j].z + v[j].w * v[j].w); }
            const float rstd = __builtin_amdgcn_rsqf(wave_sum(s) * (1.f / DM) + 1e-6f);
            unsigned long long* o8 = (unsigned long long*)(XN + (size_t)m * DM) + lane;
#pragma unroll
            for (int j = 0; j < 4; ++j) o8[64 * j] = (unsigned long long)pk2(v[j].x * rstd, v[j].y * rstd) | ((unsigned long long)pk2(v[j].z * rstd, v[j].w * rstd) << 32);
        }
    }
    SEAM(0);
    if (IN(1)) {
        pg8::Gemm g{XN, Win_t, M, NZ, DM, DM, DM}; pg8::StaticOrder S; S.init(M, NZ, G, bx);
        pg8::EpiZ E{Z, KF, stat1, ropec, ropes};
        pg8::gemm_phase<pg8::EpiZ, pg8::StaticOrder, true, true>((LAS unsigned char*)lds, g, S, E);
    }
    SEAM(1);
    if (IN(2)) {
#ifndef NO_GQ
        { pg8::Gemm g{Z + 1024, Wuq_t, M, 768, 384, NZ, 384}; pg8::StaticOrder S; S.init(M, 768, G, bx);
          pg8::EpiQ E{Qb, stat1, ropec, ropes};
          pg8::gemm_phase<pg8::EpiQ, pg8::StaticOrder, true, true>((LAS unsigned char*)lds, g, S, E); }
#endif
#ifndef NO_GKV
        { pg8::Gemm g{Z + 1408, Wukv_t, M, 1024, 256, NZ, 256}; pg8::StaticOrder S; S.init(M, 1024, G, bx);
          pg8::EpiKV E{KF, VF, stat1};
          pg8::gemm_phase<pg8::EpiKV, pg8::StaticOrder, true, true>((LAS unsigned char*)lds, g, S, E); }
#endif
        __syncthreads();
#ifndef NO_SGU
        for (int c = vcu; c < M / 128; c += G) sgu::sgu_unit(Z, Wsb, p.in[I_BSP], p.in[I_SGUN], p.in[I_ONA], Y, c, (char*)lds);
#endif
    }
    SEAM(2);
    if (IN(3)) {
        for (int it = 0;; ++it) {
            int u;
            if (G == 256) { if (vcu < 128) { if (it > 0) break; u = vcu; } else { if (it > 1) break; u = 128 + 2 * (vcu - 128) + it; } }
            else { u = bx + it * G; if (u >= 384) break; }
            const int s_ = u - 128;
            const int rowbase = (u < 128) ? (u >> 4) * 4096 : M_P + (s_ >> 3) * 2048, q0 = (u < 128) ? (u & 15) * 256 : (s_ & 7) * 256, seq = (u < 128) ? 4096 : 2048;
            att::attn_unit(Qb, KF, VF, Y, p.in[I_ONB], rowbase, q0, seq, (char*)lds);
        }
    }
    SEAM(3);
    if (IN(4)) {
        pg8::Gemm g{Y, Wout_t, M, DM, DM, DM, DM}; pg8::StaticOrder S; S.init(M, DM, G, bx);
        pg8::EpiX1 E{p.in[I_XP], p.in[I_XS], p.out, XB, stat2};
        pg8::gemm_phase<pg8::EpiX1, pg8::StaticOrder, true, true>((LAS unsigned char*)lds, g, S, E);
    }
    SEAM(4);
    if (IN(5)) {
        pg8::Gemm g{XB, W1_t, M, FF, DM, DM, DM}; pg8::StaticOrder S; S.init(M, FF, G, bx);
        pg8::EpiF E{Fb, stat2};
        pg8::gemm_phase<pg8::EpiF, pg8::StaticOrder, true, true>((LAS unsigned char*)lds, g, S, E);
    }
    SEAM(5);
    if (IN(6)) {
        pg8::Gemm g{Fb, W2_t, M, DM, FF, FF, FF}; pg8::StaticOrder S; S.init(M, DM, G, bx);
        pg8::EpiX2 E{p.out};
        pg8::gemm_phase<pg8::EpiX2, pg8::StaticOrder, true, true>((LAS unsigned char*)lds, g, S, E);
    }
    SEAM(6);
    if (IN(7)) {
        const f32x4* gf = (const f32x4*)p.in[I_NFIN] + lane;
        for (int m = gw; m < M; m += NGW) {
            f32x4* xr = (f32x4*)(p.out + (size_t)m * DM) + lane; f32x4 v[4]; float s = 0.f;
#pragma unroll
            for (int j = 0; j < 4; ++j) { v[j] = xr[64 * j]; s += (v[j].x * v[j].x + v[j].y * v[j].y) + (v[j].z * v[j].z + v[j].w * v[j].w); }
            const float rstd = __builtin_amdgcn_rsqf(wave_sum(s) * (1.f / DM) + 1e-6f);
#pragma unroll
            for (int j = 0; j < 4; ++j) xr[64 * j] = v[j] * rstd * gf[64 * j];
        }
    }
#undef IN
#undef SEAM
}

#ifndef MK_N_LAUNCHES
#define MK_N_LAUNCHES 1
#endif
extern "C" void kernel_launch(void* const* d_in, const int* in_sizes, int n_in, void* d_out, int out_size, void* d_ws, size_t ws_size, hipStream_t stream) {
    static int grid = 0;
    if (grid == 0) {
        if (n_in != 18 || in_sizes[0] != M_P * DM || in_sizes[1] != M_S * DM || out_size != M * DM || ws_size < WS_END) {
            fprintf(stderr, "kernel_launch: unexpected shapes (n_in %d, in0 %d, in1 %d, out %d, ws %zu); nothing launched\n", n_in, n_in > 0 ? in_sizes[0] : -1, n_in > 1 ? in_sizes[1] : -1, out_size, ws_size); grid = -1; return; }
        int dev = 0, cus = 0, per_cu = 0;
        if (hipGetDevice(&dev) != hipSuccess || hipDeviceGetAttribute(&cus, hipDeviceAttributeMultiprocessorCount, dev) != hipSuccess) { grid = -1; return; }
        if (hipFuncSetAttribute((const void*)mega_fwd, hipFuncAttributeMaxDynamicSharedMemorySize, LDS_TOTAL) != hipSuccess) { fprintf(stderr, "kernel_launch: hipFuncSetAttribute failed\n"); grid = -1; return; }
        if (hipOccupancyMaxActiveBlocksPerMultiprocessor(&per_cu, (const void*)mega_fwd, NWAVES * 64, LDS_TOTAL) != hipSuccess || per_cu < 1) { fprintf(stderr, "kernel_launch: occupancy query says %d\n", per_cu); per_cu = 1; }
        (void)hipGetLastError();
        grid = cus * per_cu;
    }
    if (grid < 0) return;
    if (hipMemsetAsync((char*)d_ws + WS_BAR, 0, BAR_ZERO_BYTES, stream) != hipSuccess) { fprintf(stderr, "kernel_launch: memset failed\n"); return; }
    Params a{};
    for (int i = 0; i < 18; ++i) a.in[i] = (const float*)d_in[i];
    a.out = (float*)d_out; a.ws = (unsigned char*)d_ws;
    if (MK_N_LAUNCHES == 1) {
        a.ph_lo = 0; a.ph_hi = 8;
        void* args[] = {&a};
        const hipError_t e = hipLaunchCooperativeKernel((const void*)mega_fwd, dim3(grid), dim3(NWAVES * 64), args, LDS_TOTAL, stream);
        if (e != hipSuccess) fprintf(stderr, "kernel_launch: cooperative launch failed: %s (grid %d)\n", hipGetErrorString(e), grid);
    } else {
        for (int ph = 0; ph < 8; ++ph) { a.ph_lo = ph; a.ph_hi = ph + 1; hipLaunchKernelGGL(mega_fwd, dim3(grid), dim3(NWAVES * 64), LDS_TOTAL, stream, a); }
    }
}
```

```cpp
#include <hip/hip_runtime.h>
#include <hip/hip_cooperative_groups.h>
#include <cstdio>
#include <cstdint>
namespace pg8 {
#define PG8_LAS __attribute__((address_space(3)))
typedef unsigned short bf16_t;
typedef short bf16x8 __attribute__((ext_vector_type(8)));
typedef float f32x4 __attribute__((ext_vector_type(4)));
typedef unsigned u32x4 __attribute__((ext_vector_type(4)));
constexpr int BM = 256, BK = 64, HALF = 128, HTB = HALF * BK * 2  , STAGE_BYTES = 8 * HTB, NXCD = 8, WGM = 8;

__host__ __device__ __forceinline__ int lds_byte(int r, int c) { const int st = (r >> 4) * 2 + (c >> 5), rr = r & 15, cc = c & 31, ob = rr * 64 + cc * 2; return st * 1024 + (ob ^ (((ob >> 9) & 1) << 5)); }
__host__ __device__ __forceinline__ void stage_rc(int b, int& R, int& C) { const int st = b / 1024, sb = b % 1024, swz = sb ^ (((sb >> 9) & 1) << 5); R = (st >> 1) * 16 + swz / 64; C = (st & 1) * 32 + (swz % 64) / 2; }
__host__ __device__ __forceinline__ int perm32(int rho) { const int n = rho >> 4, i = rho & 15; return 8 * (i >> 2) + 4 * n + (i & 3); }

struct Unit { int pm, pn; };
struct Gemm { const bf16_t* A; const bf16_t* Bt; int M, N, K, lda, ldb; };

struct StaticOrder {
    int nM, nN, nwg, G, c;
    __host__ __device__ void init(int M, int N, int G_, int c_) { nM = M / BM; nN = N / BM; nwg = nM * nN; G = G_; c = c_; }
    __host__ __device__ bool next(int i, Unit& u) const {
        const long L = (long)i * G + c; if (L >= nwg) return false;
        int wgid = (int)L; { const int q = nwg / NXCD, r = nwg % NXCD, xcd = wgid % NXCD, off = wgid / NXCD; wgid = (xcd < r ? xcd * (q + 1) : r * (q + 1) + (xcd - r) * q) + off; }
        const int nig = WGM * nN, gid = wgid / nig, fm = gid * WGM, gsz = (nM - fm) < WGM ? (nM - fm) : WGM;
        u.pm = fm + ((wgid % nig) % gsz); u.pn = (wgid % nig) / gsz; return true;
    }
    __device__ __forceinline__ void a_ready(const Unit&) const {}
    __device__ __forceinline__ void done(const Unit&) const {}
};


__device__ __forceinline__ unsigned cvt_pk_bf16(float lo, float hi) { unsigned r; asm volatile("v_cvt_pk_bf16_f32 %0, %1, %2" : "=v"(r) : "v"(lo), "v"(hi)); return r; }
__device__ __forceinline__ u32x4 pack8(const f32x4 v0, const f32x4 v1) { u32x4 w; w.x = cvt_pk_bf16(v0[0], v0[1]); w.y = cvt_pk_bf16(v0[2], v0[3]); w.z = cvt_pk_bf16(v1[0], v1[1]); w.w = cvt_pk_bf16(v1[2], v1[3]); return w; }
__device__ __forceinline__ float gelu_tanh(float x) {
    const float t = x * (1.0f + 0.044715f * x * x) * (-2.0f * 0.7978845608028654f * 1.4426950408889634f);
    return x * __builtin_amdgcn_rcpf(1.0f + __builtin_amdgcn_exp2f(t));
}
__device__ __forceinline__ f32x4 gelu4(f32x4 v) { return (f32x4){gelu_tanh(v[0]), gelu_tanh(v[1]), gelu_tanh(v[2]), gelu_tanh(v[3])}; }
__device__ __forceinline__ float sumsq8(const f32x4 a, const f32x4 b) { return (a[0] * a[0] + a[1] * a[1]) + (a[2] * a[2] + a[3] * a[3]) + (b[0] * b[0] + b[1] * b[1]) + (b[2] * b[2] + b[3] * b[3]); }
__device__ __forceinline__ float sum4(const f32x4 a) { return (a[0] + a[1]) + (a[2] + a[3]); }
__device__ __forceinline__ float fq_sum(float s) { s += __shfl_xor(s, 16); s += __shfl_xor(s, 32); return s; }
__device__ __forceinline__ int row_pos(int row) { return row < 32768 ? (row & 4095) : (row & 2047); }
__device__ __forceinline__ void rope8(f32x4& v0, f32x4& v1, const float* ropec, const float* ropes, int pos, int i0) {
    const f32x4 c = *(const f32x4*)(ropec + pos * 32 + i0), s = *(const f32x4*)(ropes + pos * 32 + i0);
    const f32x4 a = v0, b = v1;
    v0[0] = a[0] * c[0] - a[1] * s[0]; v0[1] = a[0] * s[0] + a[1] * c[0];
    v0[2] = a[2] * c[1] - a[3] * s[1]; v0[3] = a[2] * s[1] + a[3] * c[1];
    v1[0] = b[0] * c[2] - b[1] * s[2]; v1[1] = b[0] * s[2] + b[1] * c[2];
    v1[2] = b[2] * c[3] - b[3] * s[3]; v1[3] = b[2] * s[3] + b[3] * c[3];
}

struct EpiZ {
    static constexpr bool PERM = true, AFTER_DRAIN = false;
    bf16_t* Z; bf16_t* KF; float* stat1; const float* ropec; const float* ropes;
    __device__ __forceinline__ void operator()(const f32x4 (&acc)[2][2][4][2], const Unit& u, int wr, int wc, int fr, int fq) const {
        asm volatile("" : "+v"(fr), "+v"(fq));
        const int row0 = u.pm * BM + wr * 64 + fr;
#pragma unroll
        for (int ai = 0; ai < 2; ++ai)
#pragma unroll
            for (int m = 0; m < 4; ++m) { const int row = row0 + ai * HALF + m * 16;
#pragma unroll
                for (int bj = 0; bj < 2; ++bj) { const int hidx = 2 * u.pn + bj; const int col8 = u.pn * BM + bj * HALF + wc * 32 + 8 * fq;
                    f32x4 v0 = acc[ai][bj][m][0], v1 = acc[ai][bj][m][1];
                    if (u.pn < 4) { v0 = gelu4(v0); v1 = gelu4(v1); *(u32x4*)(Z + (size_t)row * 1792 + col8) = pack8(v0, v1); }
                    else if (hidx <= 12) { *(u32x4*)(Z + (size_t)row * 1792 + col8) = pack8(v0, v1);
                        const float ss = fq_sum(sumsq8(v0, v1)); if (fq == 0) stat1[(size_t)row * 20 + (hidx - 8) * 4 + wc] = ss; }
                    else if (wc < 2) { rope8(v0, v1, ropec, ropes, row_pos(row), 16 * wc + 4 * fq); const u32x4 w = pack8(v0, v1);
                        bf16_t* kp = KF + (size_t)row * 768 + 128 + 32 * wc + 8 * fq;
#pragma unroll
                        for (int h = 0; h < 4; ++h) *(u32x4*)(kp + h * 192) = w; }
                } }
    }
};
struct EpiQ {
    static constexpr bool PERM = true, AFTER_DRAIN = false;
    bf16_t* Q; const float* stat1; const float* ropec; const float* ropes;
    __device__ __forceinline__ void operator()(const f32x4 (&acc)[2][2][4][2], const Unit& u, int wr, int wc, int fr, int fq) const {
        asm volatile("" : "+v"(fr), "+v"(fq));
        const int row0 = u.pm * BM + wr * 64 + fr; const float QS = 0.07216878364870322f * 1.4426950408889634f;
#pragma unroll
        for (int ai = 0; ai < 2; ++ai)
#pragma unroll
            for (int m = 0; m < 4; ++m) { const int row = row0 + ai * HALF + m * 16;
                float part = 0.f; if (fq < 3) part = sum4(*(const f32x4*)(stat1 + (size_t)row * 20 + 4 * fq));
                part = fq_sum(part); const float rs = __builtin_amdgcn_rsqf(part * (1.0f / 384.0f) + 1e-6f) * QS; const int pos = row_pos(row);
#pragma unroll
                for (int bj = 0; bj < 2; ++bj) { const int col8 = u.pn * BM + bj * HALF + wc * 32 + 8 * fq; const int d = col8 % 192;
                    f32x4 v0 = acc[ai][bj][m][0] * rs, v1 = acc[ai][bj][m][1] * rs;
                    { const bool pe = d >= 128; const int i0 = pe ? (d - 128) >> 1 : 0; f32x4 c = *(const f32x4*)(ropec + pos * 32 + i0), s = *(const f32x4*)(ropes + pos * 32 + i0);
                      if (!pe) { c = (f32x4){1.f, 1.f, 1.f, 1.f}; s = (f32x4){0.f, 0.f, 0.f, 0.f}; }
                      const f32x4 a = v0, b = v1;
                      v0[0] = a[0] * c[0] - a[1] * s[0]; v0[1] = a[0] * s[0] + a[1] * c[0]; v0[2] = a[2] * c[1] - a[3] * s[1]; v0[3] = a[2] * s[1] + a[3] * c[1];
                      v1[0] = b[0] * c[2] - b[1] * s[2]; v1[1] = b[0] * s[2] + b[1] * c[2]; v1[2] = b[2] * c[3] - b[3] * s[3]; v1[3] = b[2] * s[3] + b[3] * c[3]; }
                    *(u32x4*)(Q + (size_t)row * 768 + col8) = pack8(v0, v1); } }
    }
};
struct EpiKV {
    static constexpr bool PERM = true, AFTER_DRAIN = false;
    bf16_t* KF; bf16_t* VF; const float* stat1;
    __device__ __forceinline__ void operator()(const f32x4 (&acc)[2][2][4][2], const Unit& u, int wr, int wc, int fr, int fq) const {
        asm volatile("" : "+v"(fr), "+v"(fq));
        const int row0 = u.pm * BM + wr * 64 + fr;
#pragma unroll
        for (int ai = 0; ai < 2; ++ai)
#pragma unroll
            for (int m = 0; m < 4; ++m) { const int row = row0 + ai * HALF + m * 16;
                float part = 0.f; if (fq < 2) part = sum4(*(const f32x4*)(stat1 + (size_t)row * 20 + 12 + 4 * fq));
                part = fq_sum(part); const float rs = __builtin_amdgcn_rsqf(part * (1.0f / 256.0f) + 1e-6f);
#pragma unroll
                for (int bj = 0; bj < 2; ++bj) { const int cin = wc * 32 + 8 * fq;
                    const f32x4 v0 = acc[ai][bj][m][0] * rs, v1 = acc[ai][bj][m][1] * rs;
                    bf16_t* dst = (u.pn < 2) ? KF + (size_t)row * 768 + (2 * u.pn + bj) * 192 + cin : VF + (size_t)row * 512 + (2 * (u.pn - 2) + bj) * 128 + cin;
                    *(u32x4*)dst = pack8(v0, v1); } }
    }
};
struct EpiX1 {
    static constexpr bool PERM = true, AFTER_DRAIN = false;
    const float* xp; const float* xs; float* X1; bf16_t* XB; float* stat2;
    __device__ __forceinline__ void operator()(const f32x4 (&acc)[2][2][4][2], const Unit& u, int wr, int wc, int fr, int fq) const {
        asm volatile("" : "+v"(fr), "+v"(fq));
        const int row0 = u.pm * BM + wr * 64 + fr;
        const float* xb = (u.pm < 128) ? xp : xs; const size_t xsub = (u.pm < 128) ? 0 : (size_t)32768 * 1024;
#pragma unroll
        for (int ai = 0; ai < 2; ++ai)
#pragma unroll
            for (int m = 0; m < 4; ++m) { const int row = row0 + ai * HALF + m * 16; float ss = 0.f;
#pragma unroll
                for (int bj = 0; bj < 2; ++bj) { const size_t off = (size_t)row * 1024 + u.pn * BM + bj * HALF + wc * 32 + 8 * fq;
                    const f32x4 v0 = acc[ai][bj][m][0] + *(const f32x4*)(xb + (off - xsub)), v1 = acc[ai][bj][m][1] + *(const f32x4*)(xb + (off - xsub) + 4);
                    *(u32x4*)(XB + off) = pack8(v0, v1); ss += sumsq8(v0, v1); }
                ss = fq_sum(ss); if (fq == 0) stat2[(size_t)row * 16 + u.pn * 4 + wc] = ss; }
    }
};
struct EpiF {
    static constexpr bool PERM = true, AFTER_DRAIN = false;
    bf16_t* F; const float* stat2;
    __device__ __forceinline__ void operator()(const f32x4 (&acc)[2][2][4][2], const Unit& u, int wr, int wc, int fr, int fq) const {
        asm volatile("" : "+v"(fr), "+v"(fq));
        const int row0 = u.pm * BM + wr * 64 + fr;
#pragma unroll
        for (int ai = 0; ai < 2; ++ai)
#pragma unroll
            for (int m = 0; m < 4; ++m) { const int row = row0 + ai * HALF + m * 16;
                const float part = fq_sum(sum4(*(const f32x4*)(stat2 + (size_t)row * 16 + 4 * fq))); const float rs = __builtin_amdgcn_rsqf(part * (1.0f / 1024.0f) + 1e-6f);
#pragma unroll
                for (int bj = 0; bj < 2; ++bj) { const size_t off = (size_t)row * 4096 + u.pn * BM + bj * HALF + wc * 32 + 8 * fq;
                    f32x4 v0 = acc[ai][bj][m][0] * rs, v1 = acc[ai][bj][m][1] * rs;
#pragma unroll
                    for (int e = 0; e < 4; ++e) { const float a = fmaxf(v0[e], 0.f), b = fmaxf(v1[e], 0.f); v0[e] = a * a; v1[e] = b * b; }
                    *(u32x4*)(F + off) = pack8(v0, v1); } }
    }
};
struct EpiX2 {
    static constexpr bool PERM = true, AFTER_DRAIN = false;
    float* X; const bf16_t* XB;
    __device__ __forceinline__ void operator()(const f32x4 (&acc)[2][2][4][2], const Unit& u, int wr, int wc, int fr, int fq) const {
        asm volatile("" : "+v"(fr), "+v"(fq));
        const int row0 = u.pm * BM + wr * 64 + fr;
#pragma unroll
        for (int ai = 0; ai < 2; ++ai)
#pragma unroll
            for (int m = 0; m < 4; ++m) { const int row = row0 + ai * HALF + m * 16;
#pragma unroll
                for (int bj = 0; bj < 2; ++bj) { const size_t off = (size_t)row * 1024 + u.pn * BM + bj * HALF + wc * 32 + 8 * fq;
                    const u32x4 xb = *(const u32x4*)(XB + off);
                    const f32x4 r0 = {__uint_as_float(xb.x << 16), __uint_as_float(xb.x & 0xffff0000u), __uint_as_float(xb.y << 16), __uint_as_float(xb.y & 0xffff0000u)};
                    const f32x4 r1 = {__uint_as_float(xb.z << 16), __uint_as_float(xb.z & 0xffff0000u), __uint_as_float(xb.w << 16), __uint_as_float(xb.w & 0xffff0000u)};
                    *(f32x4*)(X + off) = acc[ai][bj][m][0] + r0; *(f32x4*)(X + off + 4) = acc[ai][bj][m][1] + r1; } }
    }
};
template <class Epi, class Sched, bool ALIGN_EPI = false, bool SP2 = false>
__device__ __forceinline__ void gemm_phase(PG8_LAS unsigned char* lds, const Gemm g, const Sched& S, const Epi& E) {
    int tid_ = threadIdx.x; asm volatile("" : "+v"(tid_));
    const int tid = tid_, wid = __builtin_amdgcn_readfirstlane(tid >> 6), lane = tid & 63, wr = wid >> 2, wc = wid & 3, fr = lane & 15, fq = lane >> 4;
    const int K = g.K, nt = K / BK;
    unsigned voffA[2], voffB[2];
#pragma unroll
    for (int i = 0; i < 2; ++i) { int R, C; stage_rc(tid * 16 + i * 8192, R, C); const int Rb = Epi::PERM ? ((R & ~31) + perm32(R & 31)) : R;
        voffA[i] = (unsigned)(R * g.lda + C) * 2u; voffB[i] = (unsigned)(Rb * g.ldb + C) * 2u; }
    const size_t kstep = (size_t)(BK * 2);
    const size_t hstepA = (size_t)HALF * g.lda * 2, hstepB = (size_t)HALF * g.ldb * 2;
    const size_t tstepA = 2 * hstepA, tstepB = 2 * hstepB;
    const unsigned ldsw = (unsigned)wid * 1024u;
    const int aoff = lds_byte(wr * 64 + fr, fq * 8), boff = lds_byte(wc * 32 + fr, fq * 8);
#define PG8_SA(b, h) (((b) * 2 + (h)) * HTB)
#define PG8_SB(b, h) ((4 + (b) * 2 + (h)) * HTB)
#define PG8_STAGE(bufoff, gbase, voff) do { _Pragma("unroll") for (int _i = 0; _i < 2; ++_i) \
        __builtin_amdgcn_global_load_lds((const unsigned*)((const char*)(gbase) + (voff)[_i]), (PG8_LAS unsigned*)(lds + (bufoff) + ldsw + _i * 8192), 16, 0, 0); } while (0)
#define PG8_LDA(dst, b, h) do { _Pragma("unroll") for (int m = 0; m < 4; ++m) _Pragma("unroll") for (int k = 0; k < 2; ++k) dst[m][k] = *(const PG8_LAS bf16x8*)(lds + PG8_SA(b, h) + aoff + m * 2048 + k * 1024); } while (0)
#define PG8_LDB(dst, b, h) do { _Pragma("unroll") for (int n = 0; n < 2; ++n) _Pragma("unroll") for (int k = 0; k < 2; ++k) dst[n][k] = *(const PG8_LAS bf16x8*)(lds + PG8_SB(b, h) + boff + n * 2048 + k * 1024); } while (0)
#define PG8_MMA(ai, bj, At, Bt) do { __builtin_amdgcn_s_setprio(1); _Pragma("unroll") for (int m = 0; m < 4; ++m) _Pragma("unroll") for (int n = 0; n < 2; ++n) _Pragma("unroll") for (int k = 0; k < 2; ++k) \
        acc[ai][bj][m][n] = __builtin_amdgcn_mfma_f32_16x16x32_bf16(Bt[n][k], At[m][k], acc[ai][bj][m][n], 0, 0, 0); __builtin_amdgcn_s_setprio(0); } while (0)
#define PG8_WAIT_V(n) asm volatile("s_waitcnt vmcnt(" #n ")" ::: "memory")
#define PG8_WAIT_L(n) asm volatile("s_waitcnt lgkmcnt(" #n ")" ::: "memory")
#define PG8_BAR __builtin_amdgcn_s_barrier()
#define PG8_SCHED __builtin_amdgcn_sched_barrier(0)
    Unit cur, nxt; int ui = 0;
    if (!S.next(0, cur)) return;
    f32x4 acc[2][2][4][2];
#pragma unroll
    for (int a = 0; a < 2; ++a)
#pragma unroll
        for (int b = 0; b < 2; ++b)
#pragma unroll
            for (int m = 0; m < 4; ++m)
#pragma unroll
                for (int n = 0; n < 2; ++n) acc[a][b][m][n] = (f32x4){0.f, 0.f, 0.f, 0.f};
    bf16x8 At[4][2], B0[2][2], B1[2][2];
    const char* cA = (const char*)g.A + (size_t)cur.pm * tstepA; const char* cB = (const char*)g.Bt + (size_t)cur.pn * tstepB;
    S.a_ready(cur);
    if constexpr (SP2) {
        PG8_STAGE(PG8_SB(0, 0), cB, voffB); PG8_STAGE(PG8_SB(0, 1), cB + hstepB, voffB); PG8_STAGE(PG8_SA(0, 0), cA, voffA); PG8_STAGE(PG8_SA(0, 1), cA + hstepA, voffA);
        if (wr == 1) PG8_BAR;
        PG8_WAIT_V(2); PG8_BAR;
        PG8_STAGE(PG8_SB(1, 0), cB + kstep, voffB); PG8_STAGE(PG8_SA(1, 0), cA + kstep, voffA); PG8_STAGE(PG8_SB(1, 1), cB + hstepB + kstep, voffB);
        PG8_WAIT_V(6); PG8_BAR;
    } else {
        PG8_STAGE(PG8_SB(0, 0), cB, voffB); PG8_STAGE(PG8_SA(0, 0), cA, voffA); PG8_STAGE(PG8_SB(0, 1), cB + hstepB, voffB); PG8_STAGE(PG8_SA(0, 1), cA + hstepA, voffA);
        if (wr == 1) PG8_BAR;
        PG8_WAIT_V(4); PG8_BAR;
        PG8_STAGE(PG8_SB(1, 0), cB + kstep, voffB); PG8_STAGE(PG8_SA(1, 0), cA + kstep, voffA); PG8_STAGE(PG8_SB(1, 1), cB + hstepB + kstep, voffB);
        PG8_WAIT_V(6); PG8_BAR;
    }
    for (;;) {
        const bool has_next = S.next(ui + 1, nxt);
        const char* nA = has_next ? (const char*)g.A + (size_t)nxt.pm * tstepA : cA; const char* nB = has_next ? (const char*)g.Bt + (size_t)nxt.pn * tstepB : cB;
#pragma unroll 1
        for (int t = 0; t < nt; t += 2) {
            const bool last = (t == nt - 2);
            const char* a1 = cA + (size_t)(t + 1) * kstep;
            const char* a2 = last ? nA : cA + (size_t)(t + 2) * kstep; const char* b2 = last ? nB : cB + (size_t)(t + 2) * kstep;
            const char* a3 = a2 + kstep; const char* b3 = b2 + kstep;
            if (last && has_next) S.a_ready(nxt);
            if constexpr (SP2) {
            PG8_LDB(B0, 0, 0); PG8_LDB(B1, 0, 1); PG8_SCHED; PG8_LDA(At, 0, 0); PG8_STAGE(PG8_SA(1, 1), a1 + hstepA, voffA);
            PG8_WAIT_V(8); PG8_WAIT_L(0); PG8_BAR; PG8_MMA(0, 0, At, B0); PG8_MMA(0, 1, At, B1); PG8_BAR; PG8_SCHED;
            PG8_LDA(At, 0, 1); PG8_STAGE(PG8_SB(0, 0), b2, voffB); PG8_STAGE(PG8_SB(0, 1), b2 + hstepB, voffB); PG8_STAGE(PG8_SA(0, 0), a2, voffA);
            PG8_WAIT_V(8); PG8_WAIT_L(0); PG8_BAR; PG8_MMA(1, 0, At, B0); PG8_MMA(1, 1, At, B1); PG8_BAR; PG8_SCHED;
            PG8_LDB(B0, 1, 0); PG8_LDB(B1, 1, 1); PG8_SCHED; PG8_LDA(At, 1, 0); PG8_STAGE(PG8_SA(0, 1), a2 + hstepA, voffA);
            PG8_WAIT_V(8); PG8_WAIT_L(0); PG8_BAR; PG8_MMA(0, 0, At, B0); PG8_MMA(0, 1, At, B1); PG8_BAR; PG8_SCHED;
            PG8_LDA(At, 1, 1); PG8_STAGE(PG8_SB(1, 0), b3, voffB); PG8_STAGE(PG8_SB(1, 1), b3 + hstepB, voffB); PG8_STAGE(PG8_SA(1, 0), a3, voffA);
            PG8_WAIT_V(8); PG8_WAIT_L(0); PG8_BAR; PG8_MMA(1, 0, At, B0); PG8_MMA(1, 1, At, B1); PG8_BAR; PG8_SCHED;
            } else {
            PG8_LDB(B0, 0, 0); PG8_SCHED; PG8_LDA(At, 0, 0); PG8_STAGE(PG8_SA(1, 1), a1 + hstepA, voffA);
            PG8_WAIT_L(8); PG8_BAR; PG8_WAIT_L(0); PG8_MMA(0, 0, At, B0); PG8_BAR; PG8_SCHED;
            PG8_LDB(B1, 0, 1); PG8_STAGE(PG8_SB(0, 0), b2, voffB);
            PG8_BAR; PG8_WAIT_L(0); PG8_MMA(0, 1, At, B1); PG8_BAR;
            PG8_LDA(At, 0, 1); PG8_STAGE(PG8_SA(0, 0), a2, voffA);
            PG8_BAR; PG8_WAIT_L(0); PG8_MMA(1, 0, At, B0); PG8_BAR; PG8_SCHED;
            PG8_STAGE(PG8_SB(0, 1), b2 + hstepB, voffB);
            PG8_WAIT_V(6); PG8_BAR; PG8_MMA(1, 1, At, B1); PG8_BAR;
            PG8_LDB(B0, 1, 0); PG8_SCHED; PG8_LDA(At, 1, 0); PG8_STAGE(PG8_SA(0, 1), a2 + hstepA, voffA);
            PG8_WAIT_L(8); PG8_BAR; PG8_WAIT_L(0); PG8_MMA(0, 0, At, B0); PG8_BAR; PG8_SCHED;
            PG8_LDB(B1, 1, 1); PG8_STAGE(PG8_SB(1, 0), b3, voffB);
            PG8_BAR; PG8_WAIT_L(0); PG8_MMA(0, 1, At, B1); PG8_BAR;
            PG8_LDA(At, 1, 1); PG8_STAGE(PG8_SA(1, 0), a3, voffA);
            PG8_BAR; PG8_WAIT_L(0); PG8_MMA(1, 0, At, B0); PG8_BAR; PG8_SCHED;
            PG8_STAGE(PG8_SB(1, 1), b3 + hstepB, voffB);
            PG8_WAIT_V(6); PG8_BAR; PG8_MMA(1, 1, At, B1); PG8_BAR;
            }
        }
        if constexpr (ALIGN_EPI) { if (wr == 0) PG8_BAR; }
        if constexpr (!Epi::AFTER_DRAIN) { E(acc, cur, wr, wc, fr, fq); S.done(cur); }
        if (!has_next) break;
#pragma unroll
        for (int a = 0; a < 2; ++a)
#pragma unroll
            for (int b = 0; b < 2; ++b)
#pragma unroll
                for (int m = 0; m < 4; ++m)
#pragma unroll
                    for (int n = 0; n < 2; ++n) acc[a][b][m][n] = (f32x4){0.f, 0.f, 0.f, 0.f};
        cur = nxt; cA = nA; cB = nB; ++ui;
        if constexpr (ALIGN_EPI) { if (wr == 1) PG8_BAR; }
    }
    PG8_WAIT_V(0);
    if constexpr (!ALIGN_EPI) { if (wr == 0) PG8_BAR; }
    PG8_BAR;
    if constexpr (Epi::AFTER_DRAIN) { E.fused(acc, cur, wr, wc, fr, fq, lds, wid, lane); S.done(cur); }
#undef PG8_SA
#undef PG8_SB
#undef PG8_STAGE
#undef PG8_LDA
#undef PG8_LDB
#undef PG8_MMA
#undef PG8_WAIT_V
#undef PG8_WAIT_L
#undef PG8_BAR
#undef PG8_SCHED
}
}

namespace att {
using bf16x8 = __attribute__((ext_vector_type(8))) short;
using s16x4  = __attribute__((ext_vector_type(4))) short;
using f32x16 = __attribute__((ext_vector_type(16))) float;
using u32x4  = __attribute__((ext_vector_type(4))) unsigned;
typedef unsigned short bf16_t;
constexpr int DQK = 192, DV = 128, NW = 8, QBLK = 32, KVBLK = 64;
constexpr int LDQ = 768, LDK = 768, LDV = 512, LDY = 1024;
constexpr float THR = 11.5f;
constexpr int KROW = 400;
constexpr int SHM_V = KVBLK * DV * 2, SHM_K = KVBLK * KROW;
constexpr int SHM_ATTN = 2 * SHM_V + 2 * SHM_K + NW * 96 * 4;
#define KSWZ(row, colB) ((row) * KROW + (colB))
#define SBAR() __builtin_amdgcn_sched_barrier(0)
__device__ __forceinline__ int crow(int r, int hi) { return (r & 3) + 8 * (r >> 2) + 4 * hi; }
__device__ __forceinline__ unsigned cvtpk(float lo, float hi) { unsigned r; asm volatile("v_cvt_pk_bf16_f32 %0, %1, %2" : "=v"(r) : "v"(lo), "v"(hi)); return r; }

__device__ __forceinline__ void partialSM(f32x16& p0, f32x16& p1, float& m_reg, float& mn, float& alpha) {
  float pmax = p0[0];
#pragma unroll
  for (int r = 1; r < 16; ++r) pmax = fmaxf(pmax, p0[r]);
#pragma unroll
  for (int r = 0; r < 16; ++r) pmax = fmaxf(pmax, p1[r]);
  { auto rr = __builtin_amdgcn_permlane32_swap(__float_as_uint(pmax), __float_as_uint(pmax), false, false);
    pmax = fmaxf(__uint_as_float(rr[0]), __uint_as_float(rr[1])); }
  if (__builtin_expect(__all(pmax - m_reg <= THR), 1)) { mn = m_reg; alpha = 1.f; }
  else { mn = fmaxf(m_reg, pmax); alpha = __builtin_amdgcn_exp2f(m_reg - mn); m_reg = mn; }
#pragma unroll
  for (int r = 0; r < 16; ++r) p0[r] = p0[r] - mn;
#pragma unroll
  for (int r = 0; r < 16; ++r) p1[r] = p1[r] - mn;
#pragma unroll
  for (int r = 0; r < 16; ++r) p0[r] = __builtin_amdgcn_exp2f(p0[r]);
}
__device__ __forceinline__ void finishSM(f32x16& p0, f32x16& p1, float alpha, float& l_reg, bf16x8& pa0, bf16x8& pa1, bf16x8& pa2, bf16x8& pa3) {
#pragma unroll
  for (int r = 0; r < 16; ++r) p1[r] = __builtin_amdgcn_exp2f(p1[r]);
  float ps = 0;
#pragma unroll
  for (int r = 0; r < 16; ++r) ps += p0[r];
#pragma unroll
  for (int r = 0; r < 16; ++r) ps += p1[r];
  { auto rr = __builtin_amdgcn_permlane32_swap(__float_as_uint(ps), __float_as_uint(ps), false, false);
    ps = __uint_as_float(rr[0]) + __uint_as_float(rr[1]); }
  l_reg = l_reg * alpha + ps;
#define PK4(P, BASE, OUT) do { unsigned a0 = cvtpk(P[BASE + 0], P[BASE + 1]), a1 = cvtpk(P[BASE + 2], P[BASE + 3]);   \
    unsigned b0 = cvtpk(P[BASE + 4], P[BASE + 5]), b1 = cvtpk(P[BASE + 6], P[BASE + 7]);                              \
    auto r0 = __builtin_amdgcn_permlane32_swap(a0, b0, false, false); auto r1 = __builtin_amdgcn_permlane32_swap(a1, b1, false, false); \
    u32x4 w = {r0[0], r1[0], r0[1], r1[1]}; OUT = *reinterpret_cast<bf16x8*>(&w); } while (0)
  PK4(p0, 0, pa0); PK4(p0, 8, pa1); PK4(p1, 0, pa2); PK4(p1, 8, pa3);
#undef PK4
}
__device__ __forceinline__ void qkt(f32x16& p0, f32x16& p1, const char* Ks, const bf16x8* qr, int r32, int hi) {
  p0 = f32x16{}; p1 = f32x16{};
  const char* kb = Ks + r32 * KROW + hi * 16;
#pragma unroll
  for (int d0 = 0; d0 < 12; ++d0) {
    bf16x8 b0 = *reinterpret_cast<const bf16x8*>(kb + d0 * 32);
    bf16x8 b1 = *reinterpret_cast<const bf16x8*>(kb + 32 * KROW + d0 * 32);
    p0 = __builtin_amdgcn_mfma_f32_32x32x16_bf16(b0, qr[d0], p0, 0, 0, 0);
    p1 = __builtin_amdgcn_mfma_f32_32x32x16_bf16(b1, qr[d0], p1, 0, 0, 0); }
}
__device__ __forceinline__ int v_st(int k, int c) { const int kk = (k & ~0xC) | ((k & 4) << 1) | ((k & 8) >> 1); return ((kk >> 3) * 4 + (c >> 5)) * 512 + ((kk & 7) * 32 + (c & 31)) * 2; }
__device__ __forceinline__ int v_rd_base(int lane) { return ((lane & 3) << 3) | (((lane >> 2) & 3) << 6) | (((lane >> 4) & 1) << 5) | (((lane >> 5) & 1) << 8); }
constexpr int v_rd_off(int d0, int ks, int half) { return d0 * 512 + ks * 4096 + half * 2048; }
template <int OFF> __device__ __forceinline__ s16x4 tr_read(int vb) {
  s16x4 r; asm volatile("ds_read_b64_tr_b16 %0, %1 offset:%2" : "=&v"(r) : "v"(vb), "i"(OFF) : "memory"); return r;
}
#define PKV(L, H) (bf16x8){L[0], L[1], L[2], L[3], H[0], H[1], H[2], H[3]}
template <int D0> __device__ __forceinline__ void pv_one(f32x16& od, int vb, bf16x8 pa0, bf16x8 pa1, bf16x8 pa2, bf16x8 pa3) {
  const s16x4 l0 = tr_read<v_rd_off(D0, 0, 0)>(vb), h0 = tr_read<v_rd_off(D0, 0, 1)>(vb), l1 = tr_read<v_rd_off(D0, 1, 0)>(vb), h1 = tr_read<v_rd_off(D0, 1, 1)>(vb);
  const s16x4 l2 = tr_read<v_rd_off(D0, 2, 0)>(vb), h2 = tr_read<v_rd_off(D0, 2, 1)>(vb), l3 = tr_read<v_rd_off(D0, 3, 0)>(vb), h3 = tr_read<v_rd_off(D0, 3, 1)>(vb);
  asm volatile("s_waitcnt lgkmcnt(0)" ::: "memory"); SBAR();
  od = __builtin_amdgcn_mfma_f32_32x32x16_bf16(pa0, PKV(l0, h0), od, 0, 0, 0);
  od = __builtin_amdgcn_mfma_f32_32x32x16_bf16(pa1, PKV(l1, h1), od, 0, 0, 0);
  od = __builtin_amdgcn_mfma_f32_32x32x16_bf16(pa2, PKV(l2, h2), od, 0, 0, 0);
  od = __builtin_amdgcn_mfma_f32_32x32x16_bf16(pa3, PKV(l3, h3), od, 0, 0, 0);
}
__device__ __forceinline__ void pv_d0(f32x16* o, int vb, bf16x8 pa0, bf16x8 pa1, bf16x8 pa2, bf16x8 pa3) {
  pv_one<0>(o[0], vb, pa0, pa1, pa2, pa3); pv_one<1>(o[1], vb, pa0, pa1, pa2, pa3); pv_one<2>(o[2], vb, pa0, pa1, pa2, pa3); pv_one<3>(o[3], vb, pa0, pa1, pa2, pa3);
}

__device__ __forceinline__ void attn_head(const bf16_t* __restrict__ Qb, const bf16_t* __restrict__ Kh, const bf16_t* __restrict__ Vh, bf16_t* Yb, int seq, char* lds) {
  int tid_ = threadIdx.x; asm volatile("" : "+v"(tid_));
  const int tid = tid_, wid = __builtin_amdgcn_readfirstlane(tid >> 6), lane = tid & 63, r32 = lane & 31, hi = lane >> 5;
  char* V_lds = lds; char* K_lds = lds + 2 * SHM_V;
  float* ws = (float*)(lds + 2 * SHM_V + 2 * SHM_K) + wid * 96; float* li_l = ws; float* al_l = ws + 32;
  float m_reg = -1e30f, l_reg = 0; f32x16 o[4] = {}; bf16x8 qr[12];
  const bf16_t* Qw = Qb + (long)(wid * QBLK + r32) * LDQ + hi * 8;
#pragma unroll
  for (int d0 = 0; d0 < 12; ++d0) qr[d0] = *reinterpret_cast<const bf16x8*>(Qw + d0 * 16);
  const int sr = tid >> 4, sc = (tid & 15) * 8, vst0 = v_st(sr, sc), vst1 = v_st(32 + sr, sc);
  int kgo[3], klo[3];
#pragma unroll
  for (int i = 0; i < 3; ++i) { const int idx = tid + 512 * i, row = idx / 24, g = idx % 24; kgo[i] = row * LDK + g * 8; klo[i] = KSWZ(row, g * 16); }
  const int vb0 = (int)(uintptr_t)V_lds + v_rd_base(lane);
  struct { bf16x8 vs0, vs1, ks0, ks1, ks2; } sr_[1];
#define SLOAD(i, k0) do { sr_[i].vs0 = *reinterpret_cast<const bf16x8*>(&Vh[(long)((k0) + sr) * LDV + sc]); sr_[i].vs1 = *reinterpret_cast<const bf16x8*>(&Vh[(long)((k0) + 32 + sr) * LDV + sc]); \
    sr_[i].ks0 = *reinterpret_cast<const bf16x8*>(&Kh[(long)(k0) * LDK + kgo[0]]); sr_[i].ks1 = *reinterpret_cast<const bf16x8*>(&Kh[(long)(k0) * LDK + kgo[1]]); \
    sr_[i].ks2 = *reinterpret_cast<const bf16x8*>(&Kh[(long)(k0) * LDK + kgo[2]]); } while (0)
#define SWRITE(b, i) do { *(bf16x8*)(V_lds + (b) * SHM_V + vst0) = sr_[i].vs0; *(bf16x8*)(V_lds + (b) * SHM_V + vst1) = sr_[i].vs1; \
    *(bf16x8*)(K_lds + (b) * SHM_K + klo[0]) = sr_[i].ks0; *(bf16x8*)(K_lds + (b) * SHM_K + klo[1]) = sr_[i].ks1; *(bf16x8*)(K_lds + (b) * SHM_K + klo[2]) = sr_[i].ks2; } while (0)
#define SWAIT() asm volatile("s_waitcnt vmcnt(0)" ::: "memory")
#define RESC(a) do { if (__any((a) < 1.f)) { if (hi == 0) al_l[r32] = (a); asm volatile("s_waitcnt lgkmcnt(0)" ::: "memory"); \
    _Pragma("unroll") for (int d = 0; d < 4; ++d) _Pragma("unroll") for (int r = 0; r < 16; ++r) o[d][r] *= al_l[crow(r, hi)]; } } while (0)
  f32x16 pA0, pA1, pB0, pB1; float mnA, mnB, alA, alB; bf16x8 pa0, pa1, pa2, pa3; const int NT = seq / KVBLK;
  constexpr int SE = 0, SO = 0;
  SLOAD(SE, 0); asm volatile("s_waitcnt vmcnt(0)" ::: "memory"); SWRITE(0, SE); __syncthreads();
  qkt(pA0, pA1, K_lds, qr, r32, hi); partialSM(pA0, pA1, m_reg, mnA, alA);
  SLOAD(SO, KVBLK);
  SWAIT(); SWRITE(1, SO); __syncthreads();
  for (int j = 1; j + 1 < NT; j += 2) {
    SBAR(); qkt(pB0, pB1, K_lds + SHM_K, qr, r32, hi);
    finishSM(pA0, pA1, alA, l_reg, pa0, pa1, pa2, pa3); SBAR();
    SLOAD(SE, (j + 1) * KVBLK); SBAR();
    pv_d0(o, vb0, pa0, pa1, pa2, pa3); partialSM(pB0, pB1, m_reg, mnB, alB);
    __syncthreads(); SWAIT(); SWRITE(0, SE);
    RESC(alB); __syncthreads();
    SBAR(); qkt(pA0, pA1, K_lds, qr, r32, hi);
    finishSM(pB0, pB1, alB, l_reg, pa0, pa1, pa2, pa3); SBAR();
    SLOAD(SO, (j + 2) * KVBLK); SBAR();
    pv_d0(o, vb0 + SHM_V, pa0, pa1, pa2, pa3); partialSM(pA0, pA1, m_reg, mnA, alA);
    __syncthreads(); SWAIT(); SWRITE(1, SO);
    RESC(alA); __syncthreads();
  }
  SBAR(); qkt(pB0, pB1, K_lds + SHM_K, qr, r32, hi);
  finishSM(pA0, pA1, alA, l_reg, pa0, pa1, pa2, pa3); SBAR();
  pv_d0(o, vb0, pa0, pa1, pa2, pa3); partialSM(pB0, pB1, m_reg, mnB, alB);
  __syncthreads(); RESC(alB);
  finishSM(pB0, pB1, alB, l_reg, pa0, pa1, pa2, pa3); SBAR();
  pv_d0(o, vb0 + SHM_V, pa0, pa1, pa2, pa3);
  if (hi == 0) li_l[r32] = l_reg; asm volatile("s_waitcnt lgkmcnt(0)" ::: "memory");
  bf16_t* stg = (bf16_t*)(lds + SHM_ATTN) + wid * 4096;
#pragma unroll
  for (int r = 0; r < 16; ++r) { const int orow = crow(r, hi); const float rl = __builtin_amdgcn_rcpf(li_l[orow]);
#pragma unroll
    for (int d0 = 0; d0 < 4; ++d0) stg[orow * 128 + d0 * 32 + r32] = (bf16_t)(cvtpk(o[d0][r] * rl, 0.f) & 0xffffu); }
  asm volatile("s_waitcnt lgkmcnt(0)" ::: "memory");
  int le = threadIdx.x & 63; asm volatile("" : "+v"(le));
  bf16_t* Yw = Yb + (long)(wid * QBLK + (le >> 4)) * LDY + (le & 15) * 8; float* sq_l = ws + 64;
#pragma unroll
  for (int i = 0; i < 8; ++i) { const u32x4 v = *(const u32x4*)(stg + (i * 4 + (le >> 4)) * 128 + (le & 15) * 8); float s = 0.f;
#pragma unroll
    for (int e = 0; e < 4; ++e) { const float a = __uint_as_float(v[e] << 16), b = __uint_as_float(v[e] & 0xffff0000u); s += a * a + b * b; }
    s += __shfl_xor(s, 1); s += __shfl_xor(s, 2); s += __shfl_xor(s, 4); s += __shfl_xor(s, 8);
    if ((le & 15) == 0) sq_l[i * 4 + (le >> 4)] += s;
    *(u32x4*)(Yw + (long)(i * 4) * LDY) = v; }
  __syncthreads();
#undef SLOAD
#undef SWRITE
#undef SWAIT
#undef RESC
}
__device__ __forceinline__ void attn_unit(const bf16_t* Q, const bf16_t* KF, const bf16_t* VF, bf16_t* Y, const float* gb, int rowbase, int q0, int seq, char* lds) {
  int tid_ = threadIdx.x; asm volatile("" : "+v"(tid_));
  const int tid = tid_, wid = __builtin_amdgcn_readfirstlane(tid >> 6); int lane = tid & 63;
  float* sq_l = (float*)(lds + 2 * SHM_V + 2 * SHM_K) + wid * 96 + 64;
  if (lane < 32) sq_l[lane] = 0.f;
#pragma unroll 1
  for (int h = 0; h < 4; ++h)
    attn_head(Q + (long)(rowbase + q0) * LDQ + h * DQK, KF + (long)rowbase * LDK + h * DQK, VF + (long)rowbase * LDV + h * DV, Y + (long)(rowbase + q0) * LDY + 512 + h * DV, seq, lds);
  asm volatile("" : "+v"(lane));
  float ssq[8];
#pragma unroll
  for (int i = 0; i < 8; ++i) ssq[i] = __builtin_amdgcn_rsqf(sq_l[i * 4 + (lane >> 4)] * (1.0f / 512.0f) + 1e-6f);
  bf16_t* Yw = Y + (long)(rowbase + q0 + wid * QBLK + (lane >> 4)) * LDY + 512 + (lane & 15) * 8;
#pragma unroll 1
  for (int h = 0; h < 4; ++h) { const float* gp = gb + h * 128 + (lane & 15) * 8; const pg8::f32x4 g0 = *(const pg8::f32x4*)gp, g1 = *(const pg8::f32x4*)(gp + 4);
#pragma unroll
    for (int i = 0; i < 8; ++i) { bf16_t* p = Yw + (long)(i * 4) * LDY + h * 128; const u32x4 v = *(const u32x4*)p; const float rs = ssq[i]; u32x4 w;
      w.x = cvtpk(__uint_as_float(v.x << 16) * rs * g0[0], __uint_as_float(v.x & 0xffff0000u) * rs * g0[1]); w.y = cvtpk(__uint_as_float(v.y << 16) * rs * g0[2], __uint_as_float(v.y & 0xffff0000u) * rs * g0[3]);
      w.z = cvtpk(__uint_as_float(v.z << 16) * rs * g1[0], __uint_as_float(v.z & 0xffff0000u) * rs * g1[1]); w.w = cvtpk(__uint_as_float(v.w << 16) * rs * g1[2], __uint_as_float(v.w & 0xffff0000u) * rs * g1[3]);
      *(u32x4*)p = w; } }
}
#undef KSWZ
#undef SBAR
#undef PKV
}

namespace sgu {
using att::bf16x8; using att::s16x4; using att::f32x16; using att::bf16_t;
typedef unsigned u32x2 __attribute__((ext_vector_type(2)));
__device__ __forceinline__ float bf2f(unsigned short b) { return __uint_as_float((unsigned)b << 16); }
#define SG_PK(L, H) (bf16x8){L[0], L[1], L[2], L[3], H[0], H[1], H[2], H[3]}
template <int KS, int J> __device__ __forceinline__ void vread(int vbh, s16x4& l, s16x4& h) {
  l = att::tr_read<(KS >> 2) * 16384 + J * 512 + (KS & 3) * 4096>(vbh); h = att::tr_read<(KS >> 2) * 16384 + J * 512 + (KS & 3) * 4096 + 2048>(vbh);
}
__device__ __forceinline__ void sgu_unit(const bf16_t* __restrict__ Z, const bf16_t* __restrict__ Ws, const float* __restrict__ bsp, const float* __restrict__ gsgu, const float* __restrict__ ga,
                                         bf16_t* __restrict__ Y, int chunk, char* lds) {
  int tid_ = threadIdx.x; asm volatile("" : "+v"(tid_));
  const int tid = tid_, wid = __builtin_amdgcn_readfirstlane(tid >> 6), lane = tid & 63, r32 = lane & 31, hi = lane >> 5;
  const long row0 = (long)chunk * 128;
  {
    bf16x8 raw[16];
    const bf16_t* zp = Z + (row0 + wid) * 1792 + 512 + lane * 8;
#pragma unroll
    for (int i = 0; i < 16; ++i) raw[i] = *reinterpret_cast<const bf16x8*>(zp + (long)(8 * i) * 1792);
    const pg8::f32x4 g0 = *(const pg8::f32x4*)(gsgu + lane * 8), g1 = *(const pg8::f32x4*)(gsgu + lane * 8 + 4);
    char* ldst = lds + (lane >> 4) * 32768;
#pragma unroll
    for (int i = 0; i < 16; ++i) { const int row = wid + 8 * i;
      float f[8]; float ss = 0.f;
#pragma unroll
      for (int e = 0; e < 8; ++e) { f[e] = bf2f((unsigned short)raw[i][e]); ss += f[e] * f[e]; }
      ss += __shfl_xor(ss, 1); ss += __shfl_xor(ss, 2); ss += __shfl_xor(ss, 4); ss += __shfl_xor(ss, 8);
      const float rs = __builtin_amdgcn_rsqf(ss * (1.0f / 128.0f) + 1e-6f);
      pg8::f32x4 a = {f[0] * rs * g0[0], f[1] * rs * g0[1], f[2] * rs * g0[2], f[3] * rs * g0[3]}, b = {f[4] * rs * g1[0], f[5] * rs * g1[1], f[6] * rs * g1[2], f[7] * rs * g1[3]};
      *(pg8::u32x4*)(ldst + (row >> 6) * 16384 + att::v_st(row & 63, (lane & 15) * 8)) = pg8::pack8(a, b); }
  }
  __syncthreads();
  const int pb = wid >> 1, dsel = wid & 1;
  const int vb = (int)(uintptr_t)lds + att::v_rd_base(lane) + dsel * 1024;
  const long row = row0 + 32 * pb + r32;
  unsigned ypk[4][2][8]; float ssq = 0.f;
#pragma unroll
  for (int h = 0; h < 4; ++h) {
    u32x2 uu[2][4];
#pragma unroll
    for (int j = 0; j < 2; ++j)
#pragma unroll
      for (int rq = 0; rq < 4; ++rq) uu[j][rq] = *reinterpret_cast<const u32x2*>(Z + row * 1792 + h * 128 + 32 * (2 * dsel + j) + 8 * rq + 4 * hi);
    const float bb = bsp[h * 128 + 32 * pb + r32];
    const bf16_t* wp = Ws + (long)(h * 128 + 32 * pb + r32) * 128 + 8 * hi;
    bf16x8 wf[8];
#pragma unroll
    for (int ks = 0; ks < 8; ++ks) wf[ks] = *reinterpret_cast<const bf16x8*>(wp + 16 * ks);
    f32x16 acc0 = {}, acc1 = {};
    const int vbh = vb + h * 32768;
    { s16x4 l[8], hh[8];
      vread<0, 0>(vbh, l[0], hh[0]); vread<0, 1>(vbh, l[1], hh[1]); vread<1, 0>(vbh, l[2], hh[2]); vread<1, 1>(vbh, l[3], hh[3]);
      vread<2, 0>(vbh, l[4], hh[4]); vread<2, 1>(vbh, l[5], hh[5]); vread<3, 0>(vbh, l[6], hh[6]); vread<3, 1>(vbh, l[7], hh[7]);
      asm volatile("s_waitcnt lgkmcnt(0)" ::: "memory"); __builtin_amdgcn_sched_barrier(0);
#pragma unroll
      for (int ks = 0; ks < 4; ++ks) { acc0 = __builtin_amdgcn_mfma_f32_32x32x16_bf16(SG_PK(l[2 * ks], hh[2 * ks]), wf[ks], acc0, 0, 0, 0); acc1 = __builtin_amdgcn_mfma_f32_32x32x16_bf16(SG_PK(l[2 * ks + 1], hh[2 * ks + 1]), wf[ks], acc1, 0, 0, 0); } }
    { s16x4 l[8], hh[8];
      vread<4, 0>(vbh, l[0], hh[0]); vread<4, 1>(vbh, l[1], hh[1]); vread<5, 0>(vbh, l[2], hh[2]); vread<5, 1>(vbh, l[3], hh[3]);
      vread<6, 0>(vbh, l[4], hh[4]); vread<6, 1>(vbh, l[5], hh[5]); vread<7, 0>(vbh, l[6], hh[6]); vread<7, 1>(vbh, l[7], hh[7]);
      asm volatile("s_waitcnt lgkmcnt(0)" ::: "memory"); __builtin_amdgcn_sched_barrier(0);
#pragma unroll
      for (int ks = 0; ks < 4; ++ks) { acc0 = __builtin_amdgcn_mfma_f32_32x32x16_bf16(SG_PK(l[2 * ks], hh[2 * ks]), wf[4 + ks], acc0, 0, 0, 0); acc1 = __builtin_amdgcn_mfma_f32_32x32x16_bf16(SG_PK(l[2 * ks + 1], hh[2 * ks + 1]), wf[4 + ks], acc1, 0, 0, 0); } }
#pragma unroll
    for (int j = 0; j < 2; ++j)
#pragma unroll
      for (int rq = 0; rq < 4; ++rq) {
        const u32x2 u2 = uu[j][rq];
        const float u0 = __uint_as_float(u2.x << 16), u1 = __uint_as_float(u2.x & 0xffff0000u), u2f = __uint_as_float(u2.y << 16), u3 = __uint_as_float(u2.y & 0xffff0000u);
        const f32x16& ac = j ? acc1 : acc0;
        const float y0 = (ac[4 * rq + 0] + bb) * u0, y1 = (ac[4 * rq + 1] + bb) * u1, y2 = (ac[4 * rq + 2] + bb) * u2f, y3 = (ac[4 * rq + 3] + bb) * u3;
        ypk[h][j][2 * rq] = pg8::cvt_pk_bf16(y0, y1); ypk[h][j][2 * rq + 1] = pg8::cvt_pk_bf16(y2, y3);
        ssq += (y0 * y0 + y1 * y1) + (y2 * y2 + y3 * y3); }
  }
  ssq += __shfl_xor(ssq, 32);
  float* xs = (float*)(lds + 131072);
  if (hi == 0) xs[wid * 32 + r32] = ssq;
  __syncthreads();
  const float tot = xs[wid * 32 + r32] + xs[(wid ^ 1) * 32 + r32];
  const float rs = __builtin_amdgcn_rsqf(tot * (1.0f / 512.0f) + 1e-6f);
#pragma unroll
  for (int h = 0; h < 4; ++h)
#pragma unroll
    for (int j = 0; j < 2; ++j)
#pragma unroll
      for (int rq = 0; rq < 4; ++rq) { const int c = h * 128 + 32 * (2 * dsel + j) + 8 * rq + 4 * hi; const pg8::f32x4 gg = *(const pg8::f32x4*)(ga + c);
        const unsigned p0 = ypk[h][j][2 * rq], p1 = ypk[h][j][2 * rq + 1];
        u32x2 w; w.x = pg8::cvt_pk_bf16(__uint_as_float(p0 << 16) * rs * gg[0], __uint_as_float(p0 & 0xffff0000u) * rs * gg[1]); w.y = pg8::cvt_pk_bf16(__uint_as_float(p1 << 16) * rs * gg[2], __uint_as_float(p1 & 0xffff0000u) * rs * gg[3]);
        *reinterpret_cast<u32x2*>(Y + row * 1024 + c) = w; }
  __syncthreads();
}
#undef SG_PK
}

typedef unsigned short bf16;
typedef float f32x4 __attribute__((ext_vector_type(4)));
typedef unsigned v4u __attribute__((ext_vector_type(4)));
#define LAS __attribute__((address_space(3)))
constexpr int M_P = 8 * 4096, M_S = 32 * 2048, M = M_P + M_S;
constexpr int DM = 1024, NZ = 1792, FF = 4096;
constexpr size_t MiB = 1u << 20;
constexpr size_t WS_WIN = 1 * MiB, WS_WUQ = 5 * MiB, WS_WUKV = 6 * MiB, WS_WOUT = 7 * MiB, WS_W1 = 9 * MiB, WS_W2 = 17 * MiB, WS_WS = 25 * MiB, WS_ROPEC = 26 * MiB, WS_ROPES = 27 * MiB;
constexpr size_t WS_ST1 = 28 * MiB, WS_ST2 = 36 * MiB;
constexpr size_t WS_XN = 48 * MiB;
constexpr size_t WS_Z = 240 * MiB, WS_KF = 576 * MiB, WS_VF = 720 * MiB, WS_Y = 816 * MiB;
constexpr size_t WS_F = 240 * MiB, WS_END = 1008 * MiB;
constexpr int LDS_BYTES = att::SHM_ATTN + 65536 > 131072 + 4096 ? att::SHM_ATTN + 65536 : 131072 + 4096;
constexpr int NWAVES = 8;
constexpr int LDS_CTL_OFF = LDS_BYTES, LDS_TOTAL = LDS_BYTES + 64;
constexpr size_t WS_BAR = 0, BAR_ZERO_BYTES = 16384;

__device__ __forceinline__ unsigned f2bf(float f) { unsigned u = __builtin_bit_cast(unsigned, f); return (u + 0x7fffu + ((u >> 16) & 1u)) >> 16; }
__device__ __forceinline__ unsigned pk2(float lo, float hi) { return f2bf(lo) | (f2bf(hi) << 16); }
__device__ __forceinline__ float wave_sum(float v) {
#pragma unroll
    for (int o = 1; o < 64; o <<= 1) v += __shfl_xor(v, o);
    return v;
}
__device__ __forceinline__ int colmap(int mode, int nd) {
    if (mode == 1) { if (nd < 1664) return nd; if (nd < 1728) { const int j = nd - 1664; return 1664 + (j & 1) * 32 + (j >> 1); } return -1; }
    if (mode == 2) { const int h = nd / 192, d = nd % 192; if (d < 128) return nd; const int j = d - 128; return h * 192 + 128 + (j & 1) * 32 + (j >> 1); }
    if (mode == 3) { const int t = nd >> 9, hh = (nd >> 7) & 3, d = nd & 127; return hh * 256 + t * 128 + d; }
    return nd;
}
__device__ __forceinline__ void transpose_item(const float* W, int K, int N, int Npad, bf16* WT, const float* gain, int mode, LAS float* scr, int item, int lane) {
    const int nblk = Npad / 32, kb = item / nblk, nb = item % nblk, k0 = 64 * kb, n0 = 32 * nb;
    const int src = colmap(mode, n0 + (lane & 31));
#pragma unroll 8
    for (int i = 0; i < 32; ++i) { const int kk = 2 * i + (lane >> 5); float v = 0.f; if (src >= 0) { v = W[(size_t)(k0 + kk) * N + src]; if (gain) v *= gain[k0 + kk]; } scr[kk * 33 + (lane & 31)] = v; }
    asm volatile("s_waitcnt lgkmcnt(0)" ::: "memory");
    const int c = lane & 7;
#pragma unroll
    for (int j = 0; j < 4; ++j) { const int n = (lane >> 3) + 8 * j; const LAS float* s = scr + (8 * c) * 33 + n;
        v4u o; o.x = pk2(s[0 * 33], s[1 * 33]); o.y = pk2(s[2 * 33], s[3 * 33]); o.z = pk2(s[4 * 33], s[5 * 33]); o.w = pk2(s[6 * 33], s[7 * 33]);
        *(v4u*)(WT + (size_t)(n0 + n) * K + k0 + 8 * c) = o; }
    asm volatile("s_waitcnt lgkmcnt(0)" ::: "memory");
}
typedef __attribute__((address_space(1))) unsigned gu32;
#define XB_TMO      128
#define XB_XCNT(j)  (256  + 64 * (j))
#define XB_XSUB(j)  (1280 + 64 * (j))
#define XB_XGEN(j)  (2304 + 64 * (j))
#define XB_TOP      3328
#define XB_TOPGEN   3392
#define XCD_BAR_WORDS 3456
#define XB_SPIN_CAP (1u << 18)

__device__ __forceinline__ unsigned xb_ld(unsigned* p)              { return __hip_atomic_load(p, __ATOMIC_RELAXED, __HIP_MEMORY_SCOPE_AGENT); }
__device__ __forceinline__ unsigned xb_add(unsigned* p, unsigned v) { return __hip_atomic_fetch_add(p, v, __ATOMIC_RELAXED, __HIP_MEMORY_SCOPE_AGENT); }
__device__ __forceinline__ unsigned xb_xcc_id() { return (unsigned)__builtin_amdgcn_s_getreg((3 << 11) | 20) & 0xFu; }
#define XB_SPIN(cond, bar) do { unsigned _sp = 0; while (cond) { __builtin_amdgcn_s_sleep(1); \
    if ((++_sp & 255u) == 0u) { if (xb_ld(&(bar)[XB_TMO])) break; if (_sp > XB_SPIN_CAP) { atomicAdd(&(bar)[XB_TMO], 1u); break; } } } } while (0)

struct XcdBarrier {
    unsigned* bar; unsigned x;
    volatile LAS unsigned* st;
};

__device__ __forceinline__ XcdBarrier xcd_barrier_post(unsigned* bar, volatile LAS unsigned* st) {
    XcdBarrier b; b.bar = bar; b.x = xb_xcc_id(); b.st = st;
    if (threadIdx.x == 0) (void)xb_add(&bar[XB_XCNT(b.x)], 1u);
    return b;
}
__device__ __forceinline__ void xcd_barrier_complete(unsigned* bar, unsigned x, unsigned& nloc, unsigned& nx) {
    const unsigned G = gridDim.x * gridDim.y * gridDim.z;
    unsigned sum, cnt, mine, sp = 0u;
    for (;;) {
        sum = 0u; cnt = 0u; mine = 0u;
#pragma unroll
        for (unsigned j = 0; j < 16; ++j) { const unsigned c = xb_ld(&bar[XB_XCNT(j)]); sum += c; cnt += (c > 0u) ? 1u : 0u; mine = (j == x) ? c : mine; }
        if (sum == G) break;
        __builtin_amdgcn_s_sleep(1);
        if ((++sp & 255u) == 0u) { if (xb_ld(&bar[XB_TMO])) break; if (sp > XB_SPIN_CAP) { atomicAdd(&bar[XB_TMO], 1u); break; } }
    }
    nloc = mine > 0u ? mine : 1u; nx = cnt > 0u ? cnt : 1u;
}

__device__ __forceinline__ void xcd_barrier(const XcdBarrier& b) {
    asm volatile("s_waitcnt vmcnt(0)" ::: "memory");
    __syncthreads();
    if (threadIdx.x == 0) {
        unsigned* bar = b.bar;
        __builtin_amdgcn_s_waitcnt(0);
        unsigned nloc = b.st[0], nx = b.st[1];
        if (nloc == 0u) { xcd_barrier_complete(bar, b.x, nloc, nx); b.st[0] = nloc; b.st[1] = nx; }
        const unsigned old = xb_add(&bar[XB_XSUB(b.x)], 1u);
        const unsigned gen = old / nloc;
        if (old + 1u == (gen + 1u) * nloc) {
            __builtin_amdgcn_fence(__ATOMIC_RELEASE, "agent");
            asm volatile("s_waitcnt vmcnt(0)" ::: "memory");
            const unsigned og = xb_add(&bar[XB_TOP], 1u);
            const unsigned tg = og / nx;
            if (og + 1u == (tg + 1u) * nx) xb_add(&bar[XB_TOPGEN], 1u);
            else XB_SPIN(xb_ld(&bar[XB_TOPGEN]) == tg, bar);
            __builtin_amdgcn_fence(__ATOMIC_ACQUIRE, "agent");
            xb_add(&bar[XB_XGEN(b.x)], 1u);
            asm volatile("s_waitcnt vmcnt(0)" ::: "memory");
        } else {
            XB_SPIN(xb_ld(&bar[XB_XGEN(b.x)]) == gen, bar);
            __builtin_amdgcn_fence(__ATOMIC_ACQUIRE, "agent");
            asm volatile("s_waitcnt vmcnt(0)" ::: "memory");
        }
    }
    __syncthreads();
}

struct Params { const float* in[18]; float* out; unsigned char* ws; int ph_lo, ph_hi; };
enum { I_XP = 0, I_XS, I_NMIX, I_WIN, I_SGUN, I_WSP, I_BSP, I_QN, I_WUQ, I_KVN, I_WUKV, I_ONA, I_ONB, I_WOUT, I_NFFN, I_W1, I_W2, I_NFIN };

__global__ void __launch_bounds__(NWAVES * 64, 2) mega_fwd(Params p) {
    extern __shared__ __attribute__((aligned(16))) unsigned char lds[];
    namespace cg = cooperative_groups;
    const int tid = threadIdx.x, lane = tid & 63, wave = __builtin_amdgcn_readfirstlane(tid >> 6);
    const int G = gridDim.x, bx = blockIdx.x;
    const int vcu = (G % 8 == 0) ? (bx % 8) * (G / 8) + bx / 8 : bx;
    unsigned char* ws = p.ws;
    bf16* Win_t = (bf16*)(ws + WS_WIN); bf16* Wuq_t = (bf16*)(ws + WS_WUQ); bf16* Wukv_t = (bf16*)(ws + WS_WUKV); bf16* Wout_t = (bf16*)(ws + WS_WOUT);
    bf16* W1_t = (bf16*)(ws + WS_W1); bf16* W2_t = (bf16*)(ws + WS_W2); bf16* Wsb = (bf16*)(ws + WS_WS);
    float* ropec = (float*)(ws + WS_ROPEC); float* ropes = (float*)(ws + WS_ROPES); float* stat1 = (float*)(ws + WS_ST1); float* stat2 = (float*)(ws + WS_ST2);
    bf16* XN = (bf16*)(ws + WS_XN); bf16* Qb = XN; bf16* XB = XN;
    bf16* Z = (bf16*)(ws + WS_Z); bf16* KF = (bf16*)(ws + WS_KF); bf16* VF = (bf16*)(ws + WS_VF); bf16* Y = (bf16*)(ws + WS_Y); bf16* Fb = (bf16*)(ws + WS_F);
    const int lo = p.ph_lo, hi_ = p.ph_hi;
    volatile LAS unsigned* bst = (volatile LAS unsigned*)((LAS unsigned char*)lds + LDS_CTL_OFF);
    if (tid < 16) bst[tid] = 0u;
    __syncthreads();
    XcdBarrier bar; bar.bar = (unsigned*)(ws + WS_BAR); bar.x = 0; bar.st = bst;
    if (hi_ - lo > 1) bar = xcd_barrier_post((unsigned*)(ws + WS_BAR), bst);
#ifndef PHMASK
#define PHMASK 0xFF
#endif
#define IN(k) ((((PHMASK) >> (k)) & 1) && lo <= (k) && (k) < hi_)
#define SEAM(k) do { if (IN(k) && IN((k) + 1)) { if ((k) == 0) cg::this_grid().sync(); else xcd_barrier(bar); } } while (0)
    const int gw = vcu * NWAVES + wave, NGW = G * NWAVES;

    if (IN(0)) {
        LAS float* scr = (LAS float*)((LAS unsigned char*)lds + wave * 16384);
        constexpr int I_A = 16 * 56, I_B = 6 * 24, I_C = 4 * 32, I_D = 16 * 32, I_E = 16 * 128, I_F = 64 * 32;
        for (int it = gw; it < I_A + I_B + I_C + I_D + I_E + I_F; it += NGW) {
            int r = it;
            if (r < I_A) { transpose_item(p.in[I_WIN], 1024, 1728, 1792, Win_t, p.in[I_NMIX], 1, scr, r, lane); continue; } r -= I_A;
            if (r < I_B) { transpose_item(p.in[I_WUQ], 384, 768, 768, Wuq_t, p.in[I_QN], 2, scr, r, lane); continue; } r -= I_B;
            if (r < I_C) { transpose_item(p.in[I_WUKV], 256, 1024, 1024, Wukv_t, p.in[I_KVN], 3, scr, r, lane); continue; } r -= I_C;
            if (r < I_D) { transpose_item(p.in[I_WOUT], 1024, 1024, 1024, Wout_t, nullptr, 0, scr, r, lane); continue; } r -= I_D;
            if (r < I_E) { transpose_item(p.in[I_W1], 1024, 4096, 4096, W1_t, p.in[I_NFFN], 0, scr, r, lane); continue; } r -= I_E;
            transpose_item(p.in[I_W2], 4096, 1024, 1024, W2_t, nullptr, 0, scr, r, lane);
        }
        for (int i = bx * 512 + tid; i < 4 * 128 * 128 / 2; i += G * 512) { const float a = p.in[I_WSP][2 * i], b = p.in[I_WSP][2 * i + 1]; ((unsigned*)Wsb)[i] = pk2(a, b); }
        for (int i = bx * 512 + tid; i < 4096 * 32; i += G * 512) { const int pos = i >> 5, k = i & 31;
            const float inv = __builtin_amdgcn_exp2f(-(float)k * 0.41524101186092029f); const float ang = (float)pos * inv;
            const double t = (double)ang * 0.15915494309189535; const float fr = (float)(t - __builtin_floor(t));
            ropec[i] = __builtin_amdgcn_cosf(fr); ropes[i] = __builtin_amdgcn_sinf(fr); }
        for (int m = gw; m < M; m += NGW) {
            const float* xrow = (m < M_P) ? p.in[I_XP] + (size_t)m * DM : p.in[I_XS] + (size_t)(m - M_P) * DM;
            const f32x4* xr = (const f32x4*)xrow + lane; f32x4 v[4]; float s = 0.f;
#pragma unroll
            for (int j = 0; j < 4; ++j) { v[j] = xr[64 * j]; s += (v[j].x * v[j].x + v[j].y * v[j].y) + (v[j].z * v[j].z + v[j].w * v[j].w); }
            const float rstd = __builtin_amdgcn_rsqf(wave_sum(s) * (1.f / DM) + 1e-6f);
            unsigned long long* o8 = (unsigned long long*)(XN + (size_t)m * DM) + lane;
#pragma unroll
            for (int j = 0; j < 4; ++j) o8[64 * j] = (unsigned long long)pk2(v[j].x * rstd, v[j].y * rstd) | ((unsigned long long)pk2(v[j].z * rstd, v[j].w * rstd) << 32);
        }
    }
    SEAM(0);
    if (IN(1)) {
        pg8::Gemm g{XN, Win_t, M, NZ, DM, DM, DM}; pg8::StaticOrder S; S.init(M, NZ, G, bx);
        pg8::EpiZ E{Z, KF, stat1, ropec, ropes};
        pg8::gemm_phase<pg8::EpiZ, pg8::StaticOrder, true, true>((LAS unsigned char*)lds, g, S, E);
    }
    SEAM(1);
#ifndef REP2
#define REP2 1
#endif
    if (IN(2)) for (int rep_ = 0; rep_ < REP2; ++rep_) {
#ifndef NO_GQ
        { pg8::Gemm g{Z + 1024, Wuq_t, M, 768, 384, NZ, 384}; pg8::StaticOrder S; S.init(M, 768, G, bx);
          pg8::EpiQ E{Qb, stat1, ropec, ropes};
          pg8::gemm_phase<pg8::EpiQ, pg8::StaticOrder, true, true>((LAS unsigned char*)lds, g, S, E); }
#endif
#ifndef NO_GKV
        { pg8::Gemm g{Z + 1408, Wukv_t, M, 1024, 256, NZ, 256}; pg8::StaticOrder S; S.init(M, 1024, G, bx);
          pg8::EpiKV E{KF, VF, stat1};
          pg8::gemm_phase<pg8::EpiKV, pg8::StaticOrder, true, true>((LAS unsigned char*)lds, g, S, E); }
#endif
        __syncthreads();
#ifndef NO_SGU
        for (int c = vcu; c < M / 128; c += G) sgu::sgu_unit(Z, Wsb, p.in[I_BSP], p.in[I_SGUN], p.in[I_ONA], Y, c, (char*)lds);
#endif
    }
    SEAM(2);
#ifndef REP3
#define REP3 1
#endif
    if (IN(3)) for (int rep_ = 0; rep_ < REP3; ++rep_) {
        for (int it = 0;; ++it) {
            int u;
            if (G == 256) { if (vcu < 128) { if (it > 0) break; u = vcu; } else { if (it > 1) break; u = 128 + 2 * (vcu - 128) + it; } }
            else { u = bx + it * G; if (u >= 384) break; }
            const int s_ = u - 128;
            const int rowbase = (u < 128) ? (u >> 4) * 4096 : M_P + (s_ >> 3) * 2048, q0 = (u < 128) ? (u & 15) * 256 : (s_ & 7) * 256, seq = (u < 128) ? 4096 : 2048;
            att::attn_unit(Qb, KF, VF, Y, p.in[I_ONB], rowbase, q0, seq, (char*)lds);
        }
    }
    SEAM(3);
    if (IN(4)) {
        pg8::Gemm g{Y, Wout_t, M, DM, DM, DM, DM}; pg8::StaticOrder S; S.init(M, DM, G, bx);
        pg8::EpiX1 E{p.in[I_XP], p.in[I_XS], p.out, XB, stat2};
        pg8::gemm_phase<pg8::EpiX1, pg8::StaticOrder, true, true>((LAS unsigned char*)lds, g, S, E);
    }
    SEAM(4);
    if (IN(5)) {
        pg8::Gemm g{XB, W1_t, M, FF, DM, DM, DM}; pg8::StaticOrder S; S.init(M, FF, G, bx);
        pg8::EpiF E{Fb, stat2};
        pg8::gemm_phase<pg8::EpiF, pg8::StaticOrder, true, true>((LAS unsigned char*)lds, g, S, E);
    }
    SEAM(5);
    if (IN(6)) {
        pg8::Gemm g{Fb, W2_t, M, DM, FF, FF, FF}; pg8::StaticOrder S; S.init(M, DM, G, bx);
        pg8::EpiX2 E{p.out, XB};
        pg8::gemm_phase<pg8::EpiX2, pg8::StaticOrder, true, true>((LAS unsigned char*)lds, g, S, E);
    }
    SEAM(6);
    if (IN(7)) {
        const f32x4* gf = (const f32x4*)p.in[I_NFIN] + lane;
        for (int m = gw; m < M; m += NGW) {
            f32x4* xr = (f32x4*)(p.out + (size_t)m * DM) + lane; f32x4 v[4]; float s = 0.f;
#pragma unroll
            for (int j = 0; j < 4; ++j) { v[j] = xr[64 * j]; s += (v[j].x * v[j].x + v[j].y * v[j].y) + (v[j].z * v[j].z + v[j].w * v[j].w); }
            const float rstd = __builtin_amdgcn_rsqf(wave_sum(s) * (1.f / DM) + 1e-6f);
#pragma unroll
            for (int j = 0; j < 4; ++j) xr[64 * j] = v[j] * rstd * gf[64 * j];
        }
    }
#undef IN
#undef SEAM
}

#ifndef MK_N_LAUNCHES
#define MK_N_LAUNCHES 1
#endif
extern "C" void kernel_launch(void* const* d_in, const int* in_sizes, int n_in, void* d_out, int out_size, void* d_ws, size_t ws_size, hipStream_t stream) {
    static int grid = 0;
    if (grid == 0) {
        if (n_in != 18 || in_sizes[0] != M_P * DM || in_sizes[1] != M_S * DM || out_size != M * DM || ws_size < WS_END) {
            fprintf(stderr, "kernel_launch: unexpected shapes (n_in %d, in0 %d, in1 %d, out %d, ws %zu); nothing launched\n", n_in, n_in > 0 ? in_sizes[0] : -1, n_in > 1 ? in_sizes[1] : -1, out_size, ws_size); grid = -1; return; }
        int dev = 0, cus = 0, per_cu = 0;
        if (hipGetDevice(&dev) != hipSuccess || hipDeviceGetAttribute(&cus, hipDeviceAttributeMultiprocessorCount, dev) != hipSuccess) { grid = -1; return; }
        if (hipFuncSetAttribute((const void*)mega_fwd, hipFuncAttributeMaxDynamicSharedMemorySize, LDS_TOTAL) != hipSuccess) { fprintf(stderr, "kernel_launch: hipFuncSetAttribute failed\n"); grid = -1; return; }
        if (hipOccupancyMaxActiveBlocksPerMultiprocessor(&per_cu, (const void*)mega_fwd, NWAVES * 64, LDS_TOTAL) != hipSuccess || per_cu < 1) { fprintf(stderr, "kernel_launch: occupancy query says %d\n", per_cu); per_cu = 1; }
        (void)hipGetLastError();
        grid = cus * per_cu;
    }
    if (grid < 0) return;
    if (hipMemsetAsync((char*)d_ws + WS_BAR, 0, BAR_ZERO_BYTES, stream) != hipSuccess) { fprintf(stderr, "kernel_launch: memset failed\n"); return; }
    Params a{};
    for (int i = 0; i < 18; ++i) a.in[i] = (const float*)d_in[i];
    a.out = (float*)d_out; a.ws = (unsigned char*)d_ws;
    if (MK_N_LAUNCHES == 1) {
        a.ph_lo = 0; a.ph_hi = 8;
        void* args[] = {&a};
        const hipError_t e = hipLaunchCooperativeKernel((const void*)mega_fwd, dim3(grid), dim3(NWAVES * 64), args, LDS_TOTAL, stream);
        if (e != hipSuccess) fprintf(stderr, "kernel_launch: cooperative launch failed: %s (grid %d)\n", hipGetErrorString(e), grid);
    } else {
        for (int ph = 0; ph < 8; ++ph) { a.ph_lo = ph; a.ph_hi = ph + 1; hipLaunchKernelGGL(mega_fwd, dim3(grid), dim3(NWAVES * 64), LDS_TOTAL, stream, a); }
    }
}
```

```cpp
#include <hip/hip_runtime.h>
#include <hip/hip_cooperative_groups.h>
#include <cstdio>
#include <cstdint>
namespace pg8 {
#define PG8_LAS __attribute__((address_space(3)))
typedef unsigned short bf16_t;
typedef short bf16x8 __attribute__((ext_vector_type(8)));
typedef float f32x4 __attribute__((ext_vector_type(4)));
typedef unsigned u32x4 __attribute__((ext_vector_type(4)));
constexpr int BM = 256, BK = 64, HALF = 128, HTB = HALF * BK * 2  , STAGE_BYTES = 8 * HTB, NXCD = 8, WGM = 8;

__host__ __device__ __forceinline__ int lds_byte(int r, int c) { const int st = (r >> 4) * 2 + (c >> 5), rr = r & 15, cc = c & 31, ob = rr * 64 + cc * 2; return st * 1024 + (ob ^ (((ob >> 9) & 1) << 5)); }
__host__ __device__ __forceinline__ void stage_rc(int b, int& R, int& C) { const int st = b / 1024, sb = b % 1024, swz = sb ^ (((sb >> 9) & 1) << 5); R = (st >> 1) * 16 + swz / 64; C = (st & 1) * 32 + (swz % 64) / 2; }
__host__ __device__ __forceinline__ int perm32(int rho) { const int n = rho >> 4, i = rho & 15; return 8 * (i >> 2) + 4 * n + (i & 3); }

struct Unit { int pm, pn; };
struct Gemm { const bf16_t* A; const bf16_t* Bt; int M, N, K, lda, ldb; };

struct StaticOrder {
    int nM, nN, nwg, G, c;
    __host__ __device__ void init(int M, int N, int G_, int c_) { nM = M / BM; nN = N / BM; nwg = nM * nN; G = G_; c = c_; }
    __host__ __device__ bool next(int i, Unit& u) const {
        const long L = (long)i * G + c; if (L >= nwg) return false;
        int wgid = (int)L; { const int q = nwg / NXCD, r = nwg % NXCD, xcd = wgid % NXCD, off = wgid / NXCD; wgid = (xcd < r ? xcd * (q + 1) : r * (q + 1) + (xcd - r) * q) + off; }
        const int nig = WGM * nN, gid = wgid / nig, fm = gid * WGM, gsz = (nM - fm) < WGM ? (nM - fm) : WGM;
        u.pm = fm + ((wgid % nig) % gsz); u.pn = (wgid % nig) / gsz; return true;
    }
    __device__ __forceinline__ void a_ready(const Unit&) const {}
    __device__ __forceinline__ void done(const Unit&) const {}
};


__device__ __forceinline__ unsigned cvt_pk_bf16(float lo, float hi) { unsigned r; asm("v_cvt_pk_bf16_f32 %0, %1, %2" : "=v"(r) : "v"(lo), "v"(hi)); return r; }
__device__ __forceinline__ u32x4 pack8(const f32x4 v0, const f32x4 v1) { u32x4 w; w.x = cvt_pk_bf16(v0[0], v0[1]); w.y = cvt_pk_bf16(v0[2], v0[3]); w.z = cvt_pk_bf16(v1[0], v1[1]); w.w = cvt_pk_bf16(v1[2], v1[3]); return w; }
__device__ __forceinline__ float gelu_tanh(float x) {
    const float t = x * (1.0f + 0.044715f * x * x) * (-2.0f * 0.7978845608028654f * 1.4426950408889634f);
    return x * __builtin_amdgcn_rcpf(1.0f + __builtin_amdgcn_exp2f(t));
}
__device__ __forceinline__ f32x4 gelu4(f32x4 v) { return (f32x4){gelu_tanh(v[0]), gelu_tanh(v[1]), gelu_tanh(v[2]), gelu_tanh(v[3])}; }
__device__ __forceinline__ float sumsq8(const f32x4 a, const f32x4 b) { return (a[0] * a[0] + a[1] * a[1]) + (a[2] * a[2] + a[3] * a[3]) + (b[0] * b[0] + b[1] * b[1]) + (b[2] * b[2] + b[3] * b[3]); }
__device__ __forceinline__ float sum4(const f32x4 a) { return (a[0] + a[1]) + (a[2] + a[3]); }
__device__ __forceinline__ float fq_sum(float s) { s += __shfl_xor(s, 16); s += __shfl_xor(s, 32); return s; }
__device__ __forceinline__ int row_pos(int row) { return row < 32768 ? (row & 4095) : (row & 2047); }
__device__ __forceinline__ void rope8(f32x4& v0, f32x4& v1, const float* ropec, const float* ropes, int pos, int i0) {
    const f32x4 c = *(const f32x4*)(ropec + pos * 32 + i0), s = *(const f32x4*)(ropes + pos * 32 + i0);
    const f32x4 a = v0, b = v1;
    v0[0] = a[0] * c[0] - a[1] * s[0]; v0[1] = a[0] * s[0] + a[1] * c[0];
    v0[2] = a[2] * c[1] - a[3] * s[1]; v0[3] = a[2] * s[1] + a[3] * c[1];
    v1[0] = b[0] * c[2] - b[1] * s[2]; v1[1] = b[0] * s[2] + b[1] * c[2];
    v1[2] = b[2] * c[3] - b[3] * s[3]; v1[3] = b[2] * s[3] + b[3] * c[3];
}

struct EpiZ {
    static constexpr bool PERM = true, AFTER_DRAIN = false;
    bf16_t* Z; bf16_t* KF; float* stat1; const float* ropec; const float* ropes;
    __device__ __forceinline__ void operator()(const f32x4 (&acc)[2][2][4][2], const Unit& u, int wr, int wc, int fr, int fq) const {
        asm volatile("" : "+v"(fr), "+v"(fq));
        const int row0 = u.pm * BM + wr * 64 + fr;
#pragma unroll
        for (int ai = 0; ai < 2; ++ai)
#pragma unroll
            for (int m = 0; m < 4; ++m) { const int row = row0 + ai * HALF + m * 16;
#pragma unroll
                for (int bj = 0; bj < 2; ++bj) { const int hidx = 2 * u.pn + bj; const int col8 = u.pn * BM + bj * HALF + wc * 32 + 8 * fq;
                    f32x4 v0 = acc[ai][bj][m][0], v1 = acc[ai][bj][m][1];
                    if (u.pn < 4) { v0 = gelu4(v0); v1 = gelu4(v1); *(u32x4*)(Z + (size_t)row * 1792 + col8) = pack8(v0, v1); }
                    else if (hidx <= 12) { *(u32x4*)(Z + (size_t)row * 1792 + col8) = pack8(v0, v1);
                        const float ss = fq_sum(sumsq8(v0, v1)); if (fq == 0) stat1[(size_t)row * 20 + (hidx - 8) * 4 + wc] = ss; }
                    else if (wc < 2) { rope8(v0, v1, ropec, ropes, row_pos(row), 16 * wc + 4 * fq); const u32x4 w = pack8(v0, v1);
                        bf16_t* kp = KF + (size_t)row * 768 + 128 + 32 * wc + 8 * fq;
#pragma unroll
                        for (int h = 0; h < 4; ++h) *(u32x4*)(kp + h * 192) = w; }
                } }
    }
};
struct EpiQ {
    static constexpr bool PERM = true, AFTER_DRAIN = false;
    bf16_t* Q; const float* stat1; const float* ropec; const float* ropes;
    __device__ __forceinline__ void operator()(const f32x4 (&acc)[2][2][4][2], const Unit& u, int wr, int wc, int fr, int fq) const {
        asm volatile("" : "+v"(fr), "+v"(fq));
        const int row0 = u.pm * BM + wr * 64 + fr; const float QS = 0.07216878364870322f * 1.4426950408889634f;
        f32x4 st[2][4];
#pragma unroll
        for (int ai = 0; ai < 2; ++ai)
#pragma unroll
            for (int m = 0; m < 4; ++m) st[ai][m] = (fq < 3) ? *(const f32x4*)(stat1 + (size_t)(row0 + ai * HALF + m * 16) * 20 + 4 * fq) : (f32x4){0.f, 0.f, 0.f, 0.f};
#pragma unroll
        for (int ai = 0; ai < 2; ++ai)
#pragma unroll
            for (int m = 0; m < 4; ++m) { const int row = row0 + ai * HALF + m * 16;
                const float rs = __builtin_amdgcn_rsqf(fq_sum(sum4(st[ai][m])) * (1.0f / 384.0f) + 1e-6f) * QS; const int pos = row_pos(row);
#pragma unroll
                for (int bj = 0; bj < 2; ++bj) { const int col8 = u.pn * BM + bj * HALF + wc * 32 + 8 * fq; const int d = col8 % 192;
                    f32x4 v0 = acc[ai][bj][m][0] * rs, v1 = acc[ai][bj][m][1] * rs;
                    { const bool pe = d >= 128; const int i0 = pe ? (d - 128) >> 1 : 0; f32x4 c = *(const f32x4*)(ropec + pos * 32 + i0), s = *(const f32x4*)(ropes + pos * 32 + i0);
                      if (!pe) { c = (f32x4){1.f, 1.f, 1.f, 1.f}; s = (f32x4){0.f, 0.f, 0.f, 0.f}; }
                      const f32x4 a = v0, b = v1;
                      v0[0] = a[0] * c[0] - a[1] * s[0]; v0[1] = a[0] * s[0] + a[1] * c[0]; v0[2] = a[2] * c[1] - a[3] * s[1]; v0[3] = a[2] * s[1] + a[3] * c[1];
                      v1[0] = b[0] * c[2] - b[1] * s[2]; v1[1] = b[0] * s[2] + b[1] * c[2]; v1[2] = b[2] * c[3] - b[3] * s[3]; v1[3] = b[2] * s[3] + b[3] * c[3]; }
                    *(u32x4*)(Q + (size_t)row * 768 + col8) = pack8(v0, v1); } }
    }
};
struct EpiKV {
    static constexpr bool PERM = true, AFTER_DRAIN = false;
    bf16_t* KF; bf16_t* VF; const float* stat1;
    __device__ __forceinline__ void operator()(const f32x4 (&acc)[2][2][4][2], const Unit& u, int wr, int wc, int fr, int fq) const {
        asm volatile("" : "+v"(fr), "+v"(fq));
        const int row0 = u.pm * BM + wr * 64 + fr;
        f32x4 st[2][4];
#pragma unroll
        for (int ai = 0; ai < 2; ++ai)
#pragma unroll
            for (int m = 0; m < 4; ++m) st[ai][m] = (fq < 2) ? *(const f32x4*)(stat1 + (size_t)(row0 + ai * HALF + m * 16) * 20 + 12 + 4 * fq) : (f32x4){0.f, 0.f, 0.f, 0.f};
#pragma unroll
        for (int ai = 0; ai < 2; ++ai)
#pragma unroll
            for (int m = 0; m < 4; ++m) { const int row = row0 + ai * HALF + m * 16;
                const float rs = __builtin_amdgcn_rsqf(fq_sum(sum4(st[ai][m])) * (1.0f / 256.0f) + 1e-6f);
#pragma unroll
                for (int bj = 0; bj < 2; ++bj) { const int cin = wc * 32 + 8 * fq;
                    const f32x4 v0 = acc[ai][bj][m][0] * rs, v1 = acc[ai][bj][m][1] * rs;
                    bf16_t* dst = (u.pn < 2) ? KF + (size_t)row * 768 + (2 * u.pn + bj) * 192 + cin : VF + (size_t)row * 512 + (2 * (u.pn - 2) + bj) * 128 + cin;
                    *(u32x4*)dst = pack8(v0, v1); } }
    }
};
struct EpiX1 {
    static constexpr bool PERM = true, AFTER_DRAIN = false;
    const float* xp; const float* xs; float* X1; bf16_t* XB; float* stat2;
    __device__ __forceinline__ void operator()(const f32x4 (&acc)[2][2][4][2], const Unit& u, int wr, int wc, int fr, int fq) const {
        asm volatile("" : "+v"(fr), "+v"(fq));
        const int row0 = u.pm * BM + wr * 64 + fr;
        const float* xb = (u.pm < 128) ? xp : xs; const size_t xsub = (u.pm < 128) ? 0 : (size_t)32768 * 1024;
#pragma unroll
        for (int ai = 0; ai < 2; ++ai) {
            f32x4 xv[4][2][2];
#pragma unroll
            for (int m = 0; m < 4; ++m)
#pragma unroll
                for (int bj = 0; bj < 2; ++bj) { const size_t off = (size_t)(row0 + ai * HALF + m * 16) * 1024 + u.pn * BM + bj * HALF + wc * 32 + 8 * fq;
                    xv[m][bj][0] = *(const f32x4*)(xb + (off - xsub)); xv[m][bj][1] = *(const f32x4*)(xb + (off - xsub) + 4); }
#pragma unroll
            for (int m = 0; m < 4; ++m) { const int row = row0 + ai * HALF + m * 16; float ss = 0.f;
#pragma unroll
                for (int bj = 0; bj < 2; ++bj) { const size_t off = (size_t)row * 1024 + u.pn * BM + bj * HALF + wc * 32 + 8 * fq;
                    const f32x4 v0 = acc[ai][bj][m][0] + xv[m][bj][0], v1 = acc[ai][bj][m][1] + xv[m][bj][1];
                    *(u32x4*)(XB + off) = pack8(v0, v1); ss += sumsq8(v0, v1); }
                ss = fq_sum(ss); if (fq == 0) stat2[(size_t)row * 16 + u.pn * 4 + wc] = ss; }
        }
    }
};
struct EpiF {
    static constexpr bool PERM = true, AFTER_DRAIN = false;
    bf16_t* F; const float* stat2;
    __device__ __forceinline__ void operator()(const f32x4 (&acc)[2][2][4][2], const Unit& u, int wr, int wc, int fr, int fq) const {
        asm volatile("" : "+v"(fr), "+v"(fq));
        const int row0 = u.pm * BM + wr * 64 + fr;
        f32x4 st[2][4];
#pragma unroll
        for (int ai = 0; ai < 2; ++ai)
#pragma unroll
            for (int m = 0; m < 4; ++m) st[ai][m] = *(const f32x4*)(stat2 + (size_t)(row0 + ai * HALF + m * 16) * 16 + 4 * fq);
#pragma unroll
        for (int ai = 0; ai < 2; ++ai)
#pragma unroll
            for (int m = 0; m < 4; ++m) { const int row = row0 + ai * HALF + m * 16;
                const float rs = __builtin_amdgcn_rsqf(fq_sum(sum4(st[ai][m])) * (1.0f / 1024.0f) + 1e-6f);
#pragma unroll
                for (int bj = 0; bj < 2; ++bj) { const size_t off = (size_t)row * 4096 + u.pn * BM + bj * HALF + wc * 32 + 8 * fq;
                    f32x4 v0 = acc[ai][bj][m][0] * rs, v1 = acc[ai][bj][m][1] * rs;
#pragma unroll
                    for (int e = 0; e < 4; ++e) { const float a = fmaxf(v0[e], 0.f), b = fmaxf(v1[e], 0.f); v0[e] = a * a; v1[e] = b * b; }
                    *(u32x4*)(F + off) = pack8(v0, v1); } }
    }
};
struct EpiX2 {
    static constexpr bool PERM = true, AFTER_DRAIN = false;
    float* X; const bf16_t* XB;
    __device__ __forceinline__ void operator()(const f32x4 (&acc)[2][2][4][2], const Unit& u, int wr, int wc, int fr, int fq) const {
        asm volatile("" : "+v"(fr), "+v"(fq));
        const int row0 = u.pm * BM + wr * 64 + fr;
        u32x4 xb[2][4][2];
#pragma unroll
        for (int ai = 0; ai < 2; ++ai)
#pragma unroll
            for (int m = 0; m < 4; ++m)
#pragma unroll
                for (int bj = 0; bj < 2; ++bj) xb[ai][m][bj] = *(const u32x4*)(XB + (size_t)(row0 + ai * HALF + m * 16) * 1024 + u.pn * BM + bj * HALF + wc * 32 + 8 * fq);
#pragma unroll
        for (int ai = 0; ai < 2; ++ai)
#pragma unroll
            for (int m = 0; m < 4; ++m) { const int row = row0 + ai * HALF + m * 16;
#pragma unroll
                for (int bj = 0; bj < 2; ++bj) { const size_t off = (size_t)row * 1024 + u.pn * BM + bj * HALF + wc * 32 + 8 * fq;
                    const u32x4 x = xb[ai][m][bj];
                    const f32x4 r0 = {__uint_as_float(x.x << 16), __uint_as_float(x.x & 0xffff0000u), __uint_as_float(x.y << 16), __uint_as_float(x.y & 0xffff0000u)};
                    const f32x4 r1 = {__uint_as_float(x.z << 16), __uint_as_float(x.z & 0xffff0000u), __uint_as_float(x.w << 16), __uint_as_float(x.w & 0xffff0000u)};
                    *(f32x4*)(X + off) = acc[ai][bj][m][0] + r0; *(f32x4*)(X + off + 4) = acc[ai][bj][m][1] + r1; } }
    }
};
struct EpiX2N {
    static constexpr bool PERM = true, AFTER_DRAIN = false;
    float* X; const bf16_t* XB; const float* gfin; float* xbuf; unsigned* cnt;
    __device__ __forceinline__ void operator()(f32x4 (&acc)[2][2][4][2], const Unit& u, int wr, int wc, int fr, int fq) const {
        asm volatile("" : "+v"(fr), "+v"(fq));
        const int row0 = u.pm * BM + wr * 64 + fr;
        { u32x4 xb[2][4][2];
#pragma unroll
          for (int ai = 0; ai < 2; ++ai)
#pragma unroll
            for (int m = 0; m < 4; ++m)
#pragma unroll
                for (int bj = 0; bj < 2; ++bj) xb[ai][m][bj] = *(const u32x4*)(XB + (size_t)(row0 + ai * HALF + m * 16) * 1024 + u.pn * BM + bj * HALF + wc * 32 + 8 * fq);
#pragma unroll
          for (int ai = 0; ai < 2; ++ai)
#pragma unroll
            for (int m = 0; m < 4; ++m) { float ss = 0.f;
#pragma unroll
                for (int bj = 0; bj < 2; ++bj) { const u32x4 x = xb[ai][m][bj];
                    const f32x4 r0 = {__uint_as_float(x.x << 16), __uint_as_float(x.x & 0xffff0000u), __uint_as_float(x.y << 16), __uint_as_float(x.y & 0xffff0000u)};
                    const f32x4 r1 = {__uint_as_float(x.z << 16), __uint_as_float(x.z & 0xffff0000u), __uint_as_float(x.w << 16), __uint_as_float(x.w & 0xffff0000u)};
                    acc[ai][bj][m][0] += r0; acc[ai][bj][m][1] += r1; ss += sumsq8(acc[ai][bj][m][0], acc[ai][bj][m][1]); }
                ss = fq_sum(ss);
                if (fq == 0) __hip_atomic_store(xbuf + (size_t)(row0 + ai * HALF + m * 16) * 16 + u.pn * 4 + wc, ss, __ATOMIC_RELAXED, __HIP_MEMORY_SCOPE_AGENT); } }
        asm volatile("s_waitcnt vmcnt(0)" ::: "memory");
        unsigned* c = cnt + 64 * u.pm;
        if (fr == 0 && fq == 0) __hip_atomic_fetch_add(c, 1u, __ATOMIC_RELAXED, __HIP_MEMORY_SCOPE_AGENT);
        { const unsigned long long t0 = __builtin_amdgcn_s_memrealtime();
          for (;;) { if ((unsigned)__builtin_amdgcn_readfirstlane(__hip_atomic_load(c, __ATOMIC_RELAXED, __HIP_MEMORY_SCOPE_AGENT)) >= 32u) break;
                     if (__builtin_amdgcn_s_memrealtime() - t0 > 2000000ull) break;
                     __builtin_amdgcn_s_sleep(2); } }
        __builtin_amdgcn_fence(__ATOMIC_ACQUIRE, "agent");
        float rs[2][4];
#pragma unroll
        for (int ai = 0; ai < 2; ++ai)
#pragma unroll
            for (int m = 0; m < 4; ++m) { float* sp = xbuf + (size_t)(row0 + ai * HALF + m * 16) * 16 + 4 * fq;
                const float p = (__hip_atomic_load(sp, __ATOMIC_RELAXED, __HIP_MEMORY_SCOPE_AGENT) + __hip_atomic_load(sp + 1, __ATOMIC_RELAXED, __HIP_MEMORY_SCOPE_AGENT))
                              + (__hip_atomic_load(sp + 2, __ATOMIC_RELAXED, __HIP_MEMORY_SCOPE_AGENT) + __hip_atomic_load(sp + 3, __ATOMIC_RELAXED, __HIP_MEMORY_SCOPE_AGENT));
                rs[ai][m] = __builtin_amdgcn_rsqf(fq_sum(p) * (1.0f / 1024.0f) + 1e-6f); }
#pragma unroll
        for (int bj = 0; bj < 2; ++bj) { const int col = u.pn * BM + bj * HALF + wc * 32 + 8 * fq; const f32x4 g0 = *(const f32x4*)(gfin + col), g1 = *(const f32x4*)(gfin + col + 4);
#pragma unroll
            for (int ai = 0; ai < 2; ++ai)
#pragma unroll
                for (int m = 0; m < 4; ++m) { float* o = X + (size_t)(row0 + ai * HALF + m * 16) * 1024 + col;
                    *(f32x4*)o = acc[ai][bj][m][0] * rs[ai][m] * g0; *(f32x4*)(o + 4) = acc[ai][bj][m][1] * rs[ai][m] * g1; } }
    }
};
struct EpiX2D {
    static constexpr bool PERM = true, AFTER_DRAIN = false;
    float* X; bf16_t* XB; const float* gfin; float* xbuf; unsigned* cnt;
    mutable int ppm, ppn;
    __device__ __forceinline__ void normalize(int pm, int pn, int wr, int wc, int fr, int fq) const {
        unsigned* c = cnt + 64 * pm;
        { const unsigned long long t0 = __builtin_amdgcn_s_memrealtime();
          for (;;) { if ((unsigned)__builtin_amdgcn_readfirstlane(__hip_atomic_load(c, __ATOMIC_RELAXED, __HIP_MEMORY_SCOPE_AGENT)) >= 32u) break;
                     if (__builtin_amdgcn_s_memrealtime() - t0 > 2000000ull) break;
                     __builtin_amdgcn_s_sleep(2); } }
        const int row0 = pm * BM + wr * 64 + fr;
        float rs[2][4];
#pragma unroll
        for (int ai = 0; ai < 2; ++ai)
#pragma unroll
            for (int m = 0; m < 4; ++m) { float* sp = xbuf + (size_t)(row0 + ai * HALF + m * 16) * 16 + 4 * fq;
                const float p = (__hip_atomic_load(sp, __ATOMIC_RELAXED, __HIP_MEMORY_SCOPE_AGENT) + __hip_atomic_load(sp + 1, __ATOMIC_RELAXED, __HIP_MEMORY_SCOPE_AGENT))
                              + (__hip_atomic_load(sp + 2, __ATOMIC_RELAXED, __HIP_MEMORY_SCOPE_AGENT) + __hip_atomic_load(sp + 3, __ATOMIC_RELAXED, __HIP_MEMORY_SCOPE_AGENT));
                rs[ai][m] = __builtin_amdgcn_rsqf(fq_sum(p) * (1.0f / 1024.0f) + 1e-6f); }
#pragma unroll
        for (int bj = 0; bj < 2; ++bj) { const int col = pn * BM + bj * HALF + wc * 32 + 8 * fq; const f32x4 g0 = *(const f32x4*)(gfin + col), g1 = *(const f32x4*)(gfin + col + 4);
            u32x4 xv[2][4];
#pragma unroll
            for (int ai = 0; ai < 2; ++ai)
#pragma unroll
                for (int m = 0; m < 4; ++m) xv[ai][m] = *(const u32x4*)(XB + (size_t)(row0 + ai * HALF + m * 16) * 1024 + col);
#pragma unroll
            for (int ai = 0; ai < 2; ++ai)
#pragma unroll
                for (int m = 0; m < 4; ++m) { float* o = X + (size_t)(row0 + ai * HALF + m * 16) * 1024 + col; const u32x4 x = xv[ai][m]; const float r = rs[ai][m];
                    const f32x4 r0 = {__uint_as_float(x.x << 16), __uint_as_float(x.x & 0xffff0000u), __uint_as_float(x.y << 16), __uint_as_float(x.y & 0xffff0000u)};
                    const f32x4 r1 = {__uint_as_float(x.z << 16), __uint_as_float(x.z & 0xffff0000u), __uint_as_float(x.w << 16), __uint_as_float(x.w & 0xffff0000u)};
                    *(f32x4*)o = r0 * r * g0; *(f32x4*)(o + 4) = r1 * r * g1; } }
    }
    __device__ __forceinline__ void operator()(const f32x4 (&acc)[2][2][4][2], const Unit& u, int wr, int wc, int fr, int fq) const {
        asm volatile("" : "+v"(fr), "+v"(fq));
        const int row0 = u.pm * BM + wr * 64 + fr;
        { u32x4 xb[2][4][2];
#pragma unroll
          for (int ai = 0; ai < 2; ++ai)
#pragma unroll
            for (int m = 0; m < 4; ++m)
#pragma unroll
                for (int bj = 0; bj < 2; ++bj) xb[ai][m][bj] = *(const u32x4*)(XB + (size_t)(row0 + ai * HALF + m * 16) * 1024 + u.pn * BM + bj * HALF + wc * 32 + 8 * fq);
#pragma unroll
          for (int ai = 0; ai < 2; ++ai)
#pragma unroll
            for (int m = 0; m < 4; ++m) { float ss = 0.f;
#pragma unroll
                for (int bj = 0; bj < 2; ++bj) { const u32x4 x = xb[ai][m][bj];
                    const f32x4 r0 = {__uint_as_float(x.x << 16), __uint_as_float(x.x & 0xffff0000u), __uint_as_float(x.y << 16), __uint_as_float(x.y & 0xffff0000u)};
                    const f32x4 r1 = {__uint_as_float(x.z << 16), __uint_as_float(x.z & 0xffff0000u), __uint_as_float(x.w << 16), __uint_as_float(x.w & 0xffff0000u)};
                    const f32x4 v0 = acc[ai][bj][m][0] + r0, v1 = acc[ai][bj][m][1] + r1; ss += sumsq8(v0, v1);
                    *(u32x4*)(XB + (size_t)(row0 + ai * HALF + m * 16) * 1024 + u.pn * BM + bj * HALF + wc * 32 + 8 * fq) = pack8(v0, v1); }
                ss = fq_sum(ss);
                if (fq == 0) __hip_atomic_store(xbuf + (size_t)(row0 + ai * HALF + m * 16) * 16 + u.pn * 4 + wc, ss, __ATOMIC_RELAXED, __HIP_MEMORY_SCOPE_AGENT); } }
        asm volatile("s_waitcnt vmcnt(0)" ::: "memory");
        if (fr == 0 && fq == 0) __hip_atomic_fetch_add(cnt + 64 * u.pm, 1u, __ATOMIC_RELAXED, __HIP_MEMORY_SCOPE_AGENT);
        asm volatile("" : "+v"(fr), "+v"(fq));
        if (ppm >= 0) normalize(ppm, ppn, wr, wc, fr, fq);
        ppm = u.pm; ppn = u.pn;
    }
    __device__ __forceinline__ void flush() const { int t = threadIdx.x; asm volatile("" : "+v"(t)); const int wid = __builtin_amdgcn_readfirstlane(t >> 6), lane = t & 63;
        if (ppm >= 0) normalize(ppm, ppn, wid >> 2, wid & 3, lane & 15, lane >> 4); ppm = -1; }
};
template <class Epi, class Sched, bool ALIGN_EPI = false, bool SP2 = false>
__device__ __forceinline__ void gemm_phase(PG8_LAS unsigned char* lds, const Gemm g, const Sched& S, const Epi& E) {
    int tid_ = threadIdx.x; asm volatile("" : "+v"(tid_));
    const int tid = tid_, wid = __builtin_amdgcn_readfirstlane(tid >> 6), lane = tid & 63, wr = wid >> 2, wc = wid & 3, fr = lane & 15, fq = lane >> 4;
    const int K = g.K, nt = K / BK;
    unsigned voffA[2], voffB[2];
#pragma unroll
    for (int i = 0; i < 2; ++i) { int R, C; stage_rc(tid * 16 + i * 8192, R, C); const int Rb = Epi::PERM ? ((R & ~31) + perm32(R & 31)) : R;
        voffA[i] = (unsigned)(R * g.lda + C) * 2u; voffB[i] = (unsigned)(Rb * g.ldb + C) * 2u; }
    const size_t kstep = (size_t)(BK * 2);
    const size_t hstepA = (size_t)HALF * g.lda * 2, hstepB = (size_t)HALF * g.ldb * 2;
    const size_t tstepA = 2 * hstepA, tstepB = 2 * hstepB;
    const unsigned ldsw = (unsigned)wid * 1024u;
    const int aoff = lds_byte(wr * 64 + fr, fq * 8), boff = lds_byte(wc * 32 + fr, fq * 8);
#define PG8_SA(b, h) (((b) * 2 + (h)) * HTB)
#define PG8_SB(b, h) ((4 + (b) * 2 + (h)) * HTB)
#define PG8_STAGE(bufoff, gbase, voff) do { _Pragma("unroll") for (int _i = 0; _i < 2; ++_i) \
        __builtin_amdgcn_global_load_lds((const unsigned*)((const char*)(gbase) + (voff)[_i]), (PG8_LAS unsigned*)(lds + (bufoff) + ldsw + _i * 8192), 16, 0, 0); } while (0)
#define PG8_LDA(dst, b, h) do { _Pragma("unroll") for (int m = 0; m < 4; ++m) _Pragma("unroll") for (int k = 0; k < 2; ++k) dst[m][k] = *(const PG8_LAS bf16x8*)(lds + PG8_SA(b, h) + aoff + m * 2048 + k * 1024); } while (0)
#define PG8_LDB(dst, b, h) do { _Pragma("unroll") for (int n = 0; n < 2; ++n) _Pragma("unroll") for (int k = 0; k < 2; ++k) dst[n][k] = *(const PG8_LAS bf16x8*)(lds + PG8_SB(b, h) + boff + n * 2048 + k * 1024); } while (0)
#define PG8_MMA(ai, bj, At, Bt) do { __builtin_amdgcn_s_setprio(1); _Pragma("unroll") for (int m = 0; m < 4; ++m) _Pragma("unroll") for (int n = 0; n < 2; ++n) _Pragma("unroll") for (int k = 0; k < 2; ++k) \
        acc[ai][bj][m][n] = __builtin_amdgcn_mfma_f32_16x16x32_bf16(Bt[n][k], At[m][k], acc[ai][bj][m][n], 0, 0, 0); __builtin_amdgcn_s_setprio(0); } while (0)
#define PG8_WAIT_V(n) asm volatile("s_waitcnt vmcnt(" #n ")" ::: "memory")
#define PG8_WAIT_L(n) asm volatile("s_waitcnt lgkmcnt(" #n ")" ::: "memory")
#define PG8_BAR __builtin_amdgcn_s_barrier()
#define PG8_SCHED __builtin_amdgcn_sched_barrier(0)
    Unit cur, nxt; int ui = 0;
    if (!S.next(0, cur)) return;
    f32x4 acc[2][2][4][2];
#pragma unroll
    for (int a = 0; a < 2; ++a)
#pragma unroll
        for (int b = 0; b < 2; ++b)
#pragma unroll
            for (int m = 0; m < 4; ++m)
#pragma unroll
                for (int n = 0; n < 2; ++n) acc[a][b][m][n] = (f32x4){0.f, 0.f, 0.f, 0.f};
    bf16x8 At[4][2], B0[2][2], B1[2][2];
    const char* cA = (const char*)g.A + (size_t)cur.pm * tstepA; const char* cB = (const char*)g.Bt + (size_t)cur.pn * tstepB;
    S.a_ready(cur);
    if constexpr (SP2) {
        PG8_STAGE(PG8_SB(0, 0), cB, voffB); PG8_STAGE(PG8_SB(0, 1), cB + hstepB, voffB); PG8_STAGE(PG8_SA(0, 0), cA, voffA); PG8_STAGE(PG8_SA(0, 1), cA + hstepA, voffA);
        if (wr == 1) PG8_BAR;
        PG8_WAIT_V(2); PG8_BAR;
        PG8_STAGE(PG8_SB(1, 0), cB + kstep, voffB); PG8_STAGE(PG8_SA(1, 0), cA + kstep, voffA); PG8_STAGE(PG8_SB(1, 1), cB + hstepB + kstep, voffB);
        PG8_WAIT_V(6); PG8_BAR;
    } else {
        PG8_STAGE(PG8_SB(0, 0), cB, voffB); PG8_STAGE(PG8_SA(0, 0), cA, voffA); PG8_STAGE(PG8_SB(0, 1), cB + hstepB, voffB); PG8_STAGE(PG8_SA(0, 1), cA + hstepA, voffA);
        if (wr == 1) PG8_BAR;
        PG8_WAIT_V(4); PG8_BAR;
        PG8_STAGE(PG8_SB(1, 0), cB + kstep, voffB); PG8_STAGE(PG8_SA(1, 0), cA + kstep, voffA); PG8_STAGE(PG8_SB(1, 1), cB + hstepB + kstep, voffB);
        PG8_WAIT_V(6); PG8_BAR;
    }
    for (;;) {
        const bool has_next = S.next(ui + 1, nxt);
        const char* nA = has_next ? (const char*)g.A + (size_t)nxt.pm * tstepA : cA; const char* nB = has_next ? (const char*)g.Bt + (size_t)nxt.pn * tstepB : cB;
#pragma unroll 1
        for (int t = 0; t < nt; t += 2) {
            const bool last = (t == nt - 2);
            const char* a1 = cA + (size_t)(t + 1) * kstep;
            const char* a2 = last ? nA : cA + (size_t)(t + 2) * kstep; const char* b2 = last ? nB : cB + (size_t)(t + 2) * kstep;
            const char* a3 = a2 + kstep; const char* b3 = b2 + kstep;
            if (last && has_next) S.a_ready(nxt);
            if constexpr (SP2) {
            PG8_LDB(B0, 0, 0); PG8_LDB(B1, 0, 1); PG8_SCHED; PG8_LDA(At, 0, 0); PG8_STAGE(PG8_SA(1, 1), a1 + hstepA, voffA);
            PG8_WAIT_V(8); PG8_WAIT_L(0); PG8_BAR; PG8_MMA(0, 0, At, B0); PG8_MMA(0, 1, At, B1); PG8_BAR; PG8_SCHED;
            PG8_LDA(At, 0, 1); PG8_STAGE(PG8_SB(0, 0), b2, voffB); PG8_STAGE(PG8_SB(0, 1), b2 + hstepB, voffB); PG8_STAGE(PG8_SA(0, 0), a2, voffA);
            PG8_WAIT_V(8); PG8_WAIT_L(0); PG8_BAR; PG8_MMA(1, 0, At, B0); PG8_MMA(1, 1, At, B1); PG8_BAR; PG8_SCHED;
            PG8_LDB(B0, 1, 0); PG8_LDB(B1, 1, 1); PG8_SCHED; PG8_LDA(At, 1, 0); PG8_STAGE(PG8_SA(0, 1), a2 + hstepA, voffA);
            PG8_WAIT_V(8); PG8_WAIT_L(0); PG8_BAR; PG8_MMA(0, 0, At, B0); PG8_MMA(0, 1, At, B1); PG8_BAR; PG8_SCHED;
            PG8_LDA(At, 1, 1); PG8_STAGE(PG8_SB(1, 0), b3, voffB); PG8_STAGE(PG8_SB(1, 1), b3 + hstepB, voffB); PG8_STAGE(PG8_SA(1, 0), a3, voffA);
            PG8_WAIT_V(8); PG8_WAIT_L(0); PG8_BAR; PG8_MMA(1, 0, At, B0); PG8_MMA(1, 1, At, B1); PG8_BAR; PG8_SCHED;
            } else {
            PG8_LDB(B0, 0, 0); PG8_SCHED; PG8_LDA(At, 0, 0); PG8_STAGE(PG8_SA(1, 1), a1 + hstepA, voffA);
            PG8_WAIT_L(8); PG8_BAR; PG8_WAIT_L(0); PG8_MMA(0, 0, At, B0); PG8_BAR; PG8_SCHED;
            PG8_LDB(B1, 0, 1); PG8_STAGE(PG8_SB(0, 0), b2, voffB);
            PG8_BAR; PG8_WAIT_L(0); PG8_MMA(0, 1, At, B1); PG8_BAR;
            PG8_LDA(At, 0, 1); PG8_STAGE(PG8_SA(0, 0), a2, voffA);
            PG8_BAR; PG8_WAIT_L(0); PG8_MMA(1, 0, At, B0); PG8_BAR; PG8_SCHED;
            PG8_STAGE(PG8_SB(0, 1), b2 + hstepB, voffB);
            PG8_WAIT_V(6); PG8_BAR; PG8_MMA(1, 1, At, B1); PG8_BAR;
            PG8_LDB(B0, 1, 0); PG8_SCHED; PG8_LDA(At, 1, 0); PG8_STAGE(PG8_SA(0, 1), a2 + hstepA, voffA);
            PG8_WAIT_L(8); PG8_BAR; PG8_WAIT_L(0); PG8_MMA(0, 0, At, B0); PG8_BAR; PG8_SCHED;
            PG8_LDB(B1, 1, 1); PG8_STAGE(PG8_SB(1, 0), b3, voffB);
            PG8_BAR; PG8_WAIT_L(0); PG8_MMA(0, 1, At, B1); PG8_BAR;
            PG8_LDA(At, 1, 1); PG8_STAGE(PG8_SA(1, 0), a3, voffA);
            PG8_BAR; PG8_WAIT_L(0); PG8_MMA(1, 0, At, B0); PG8_BAR; PG8_SCHED;
            PG8_STAGE(PG8_SB(1, 1), b3 + hstepB, voffB);
            PG8_WAIT_V(6); PG8_BAR; PG8_MMA(1, 1, At, B1); PG8_BAR;
            }
        }
        if constexpr (ALIGN_EPI) { if (wr == 0) PG8_BAR; }
        if constexpr (!Epi::AFTER_DRAIN) { E(acc, cur, wr, wc, fr, fq); S.done(cur); }
        if (!has_next) break;
#pragma unroll
        for (int a = 0; a < 2; ++a)
#pragma unroll
            for (int b = 0; b < 2; ++b)
#pragma unroll
                for (int m = 0; m < 4; ++m)
#pragma unroll
                    for (int n = 0; n < 2; ++n) acc[a][b][m][n] = (f32x4){0.f, 0.f, 0.f, 0.f};
        cur = nxt; cA = nA; cB = nB; ++ui;
        if constexpr (ALIGN_EPI) { if (wr == 1) PG8_BAR; }
    }
    PG8_WAIT_V(0);
    if constexpr (!ALIGN_EPI) { if (wr == 0) PG8_BAR; }
    PG8_BAR;
    if constexpr (Epi::AFTER_DRAIN) { E.fused(acc, cur, wr, wc, fr, fq, lds, wid, lane); S.done(cur); }
#undef PG8_SA
#undef PG8_SB
#undef PG8_STAGE
#undef PG8_LDA
#undef PG8_LDB
#undef PG8_MMA
#undef PG8_WAIT_V
#undef PG8_WAIT_L
#undef PG8_BAR
#undef PG8_SCHED
}
}

namespace att {
using bf16x8 = __attribute__((ext_vector_type(8))) short;
using s16x4  = __attribute__((ext_vector_type(4))) short;
using f32x16 = __attribute__((ext_vector_type(16))) float;
using u32x4  = __attribute__((ext_vector_type(4))) unsigned;
typedef unsigned short bf16_t;
constexpr int DQK = 192, DV = 128, NW = 8, QBLK = 32, KVBLK = 64;
constexpr int LDQ = 768, LDK = 768, LDV = 512, LDY = 1024;
constexpr float THR = 11.5f;
constexpr int KROW = 400;
constexpr int SHM_V = KVBLK * DV * 2, SHM_K = KVBLK * KROW;
constexpr int NRING = 3;
constexpr int SHM_ATTN = NRING * SHM_V + NRING * SHM_K + NW * 96 * 4;
#define KSWZ(row, colB) ((row) * KROW + (colB))
#define SBAR() __builtin_amdgcn_sched_barrier(0)
__device__ __forceinline__ int crow(int r, int hi) { return (r & 3) + 8 * (r >> 2) + 4 * hi; }
__device__ __forceinline__ unsigned cvtpk(float lo, float hi) { unsigned r; asm volatile("v_cvt_pk_bf16_f32 %0, %1, %2" : "=v"(r) : "v"(lo), "v"(hi)); return r; }

__device__ __forceinline__ void partialSM(f32x16& p0, f32x16& p1, float& m_reg, float& mn, float& alpha) {
  float pmax = p0[0];
#pragma unroll
  for (int r = 1; r < 16; ++r) pmax = fmaxf(pmax, p0[r]);
#pragma unroll
  for (int r = 0; r < 16; ++r) pmax = fmaxf(pmax, p1[r]);
  { auto rr = __builtin_amdgcn_permlane32_swap(__float_as_uint(pmax), __float_as_uint(pmax), false, false);
    pmax = fmaxf(__uint_as_float(rr[0]), __uint_as_float(rr[1])); }
  { const bool up = (pmax - m_reg) > THR; mn = up ? fmaxf(m_reg, pmax) : m_reg; alpha = up ? __builtin_amdgcn_exp2f(m_reg - mn) : 1.f; m_reg = mn; }
#pragma unroll
  for (int r = 0; r < 16; ++r) p0[r] = p0[r] - mn;
#pragma unroll
  for (int r = 0; r < 16; ++r) p1[r] = p1[r] - mn;
#pragma unroll
  for (int r = 0; r < 16; ++r) p0[r] = __builtin_amdgcn_exp2f(p0[r]);
}
__device__ __forceinline__ void finishSM(f32x16& p0, f32x16& p1, float alpha, float& l_reg, bf16x8& pa0, bf16x8& pa1, bf16x8& pa2, bf16x8& pa3) {
#pragma unroll
  for (int r = 0; r < 16; ++r) p1[r] = __builtin_amdgcn_exp2f(p1[r]);
  float ps = 0;
#pragma unroll
  for (int r = 0; r < 16; ++r) ps += p0[r];
#pragma unroll
  for (int r = 0; r < 16; ++r) ps += p1[r];
  { auto rr = __builtin_amdgcn_permlane32_swap(__float_as_uint(ps), __float_as_uint(ps), false, false);
    ps = __uint_as_float(rr[0]) + __uint_as_float(rr[1]); }
  l_reg = l_reg * alpha + ps;
#define PK4(P, BASE, OUT) do { unsigned a0 = cvtpk(P[BASE + 0], P[BASE + 1]), a1 = cvtpk(P[BASE + 2], P[BASE + 3]);   \
    unsigned b0 = cvtpk(P[BASE + 4], P[BASE + 5]), b1 = cvtpk(P[BASE + 6], P[BASE + 7]);                              \
    auto r0 = __builtin_amdgcn_permlane32_swap(a0, b0, false, false); auto r1 = __builtin_amdgcn_permlane32_swap(a1, b1, false, false); \
    u32x4 w = {r0[0], r1[0], r0[1], r1[1]}; OUT = *reinterpret_cast<bf16x8*>(&w); } while (0)
  PK4(p0, 0, pa0); PK4(p0, 8, pa1); PK4(p1, 0, pa2); PK4(p1, 8, pa3);
#undef PK4
}
__device__ __forceinline__ void qkt(f32x16& p0, f32x16& p1, const char* Ks, const bf16x8* qr, const char* qpe, int r32, int hi) {
  p0 = f32x16{}; p1 = f32x16{};
  const char* kb = Ks + r32 * KROW + hi * 16;
  bf16x8 ka[12], kc[12], qf[4];
#define KRD(d) do { ka[d] = *reinterpret_cast<const bf16x8*>(kb + (d) * 32); kc[d] = *reinterpret_cast<const bf16x8*>(kb + 32 * KROW + (d) * 32); } while (0)
#define QRD(d) do { qf[(d) - 8] = *reinterpret_cast<const bf16x8*>(qpe + ((d) - 8) * 1024); } while (0)
#define QMM(d, Q, NDS) do { p0 = __builtin_amdgcn_mfma_f32_32x32x16_bf16(ka[d], Q, p0, 0, 0, 0); p1 = __builtin_amdgcn_mfma_f32_32x32x16_bf16(kc[d], Q, p1, 0, 0, 0); \
    __builtin_amdgcn_sched_group_barrier(0x100, NDS, 0); __builtin_amdgcn_sched_group_barrier(0x008, 1, 0); __builtin_amdgcn_sched_group_barrier(0x002, 3, 0); \
    __builtin_amdgcn_sched_group_barrier(0x008, 1, 0); __builtin_amdgcn_sched_group_barrier(0x002, 3, 0); } while (0)
  KRD(0); KRD(1); __builtin_amdgcn_sched_group_barrier(0x100, 4, 0);
  KRD(2); QMM(0, qr[0], 2);
  KRD(3); QMM(1, qr[1], 2);
  KRD(4); QMM(2, qr[2], 2);
  KRD(5); QMM(3, qr[3], 2);
  KRD(6); QMM(4, qr[4], 2);
  KRD(7); QMM(5, qr[5], 2);
  KRD(8); QMM(6, qr[6], 2);
  KRD(9); QRD(8); QMM(7, qr[7], 3);
  KRD(10); QRD(9); QMM(8, qf[0], 3);
  KRD(11); QRD(10); QMM(9, qf[1], 3);
  QRD(11); QMM(10, qf[2], 1);
  QMM(11, qf[3], 0);
#undef KRD
#undef QRD
#undef QMM
}
__device__ __forceinline__ int v_st(int k, int c) { const int kk = (k & ~0xC) | ((k & 4) << 1) | ((k & 8) >> 1); return ((kk >> 3) * 4 + (c >> 5)) * 512 + ((kk & 7) * 32 + (c & 31)) * 2; }
__device__ __forceinline__ int v_rd_base(int lane) { return ((lane & 3) << 3) | (((lane >> 2) & 3) << 6) | (((lane >> 4) & 1) << 5) | (((lane >> 5) & 1) << 8); }
constexpr int v_rd_off(int d0, int ks, int half) { return d0 * 512 + ks * 4096 + half * 2048; }
template <int OFF> __device__ __forceinline__ s16x4 tr_read(int vb) {
  s16x4 r; asm volatile("ds_read_b64_tr_b16 %0, %1 offset:%2" : "=&v"(r) : "v"(vb), "i"(OFF) : "memory"); return r;
}
#define PKV(L, H) (bf16x8){L[0], L[1], L[2], L[3], H[0], H[1], H[2], H[3]}
typedef short v4i16_t __attribute__((ext_vector_type(4)));
__device__ __forceinline__ s16x4 vtr(int addr) { return __builtin_bit_cast(s16x4, __builtin_amdgcn_ds_read_tr16_b64_v4i16((__attribute__((address_space(3))) v4i16_t*)(unsigned long)(unsigned)addr)); }
__device__ __forceinline__ void pv_d0(f32x16* o, int vb, bf16x8 pa0, bf16x8 pa1, bf16x8 pa2, bf16x8 pa3) {
#define PVS(KS, D0, PA) do { const s16x4 l_ = vtr(vb + v_rd_off(D0, KS, 0)), h_ = vtr(vb + v_rd_off(D0, KS, 1)); o[D0] = __builtin_amdgcn_mfma_f32_32x32x16_bf16(PA, PKV(l_, h_), o[D0], 0, 0, 0); } while (0)
  PVS(0, 0, pa0); PVS(0, 1, pa0); PVS(0, 2, pa0); PVS(0, 3, pa0);
  PVS(1, 0, pa1); PVS(1, 1, pa1); PVS(1, 2, pa1); PVS(1, 3, pa1);
  PVS(2, 0, pa2); PVS(2, 1, pa2); PVS(2, 2, pa2); PVS(2, 3, pa2);
  PVS(3, 0, pa3); PVS(3, 1, pa3); PVS(3, 2, pa3); PVS(3, 3, pa3);
#undef PVS
}
#define PV_SCHED() do { _Pragma("unroll") for (int i_ = 0; i_ < 16; ++i_) { __builtin_amdgcn_sched_group_barrier(0x100, 2, 0); __builtin_amdgcn_sched_group_barrier(0x008, 1, 0); __builtin_amdgcn_sched_group_barrier(0x002, 6, 0); } } while (0)

__device__ __forceinline__ void attn_head(const bf16_t* __restrict__ Qb, const bf16_t* __restrict__ Kh, const bf16_t* __restrict__ Vh, bf16_t* Yb, int seq, char* lds) {
  int tid_ = threadIdx.x; asm volatile("" : "+v"(tid_));
  const int tid = tid_, wid = __builtin_amdgcn_readfirstlane(tid >> 6), lane = tid & 63, r32 = lane & 31, hi = lane >> 5;
  char* K_lds = lds; char* V_lds = lds + NRING * SHM_K;
  float* ws = (float*)(lds + NRING * SHM_V + NRING * SHM_K) + wid * 96; float* li_l = ws; float* al_l = ws + 32;
  float m_reg = -1e30f, l_reg = 0; f32x16 o[4] = {}; bf16x8 qr[8];
  char* qpe = lds + SHM_ATTN + wid * 4096 + lane * 16;
  const bf16_t* Qw = Qb + (long)(wid * QBLK + r32) * LDQ + hi * 8;
#pragma unroll
  for (int d0 = 0; d0 < 8; ++d0) qr[d0] = *reinterpret_cast<const bf16x8*>(Qw + d0 * 16);
#pragma unroll
  for (int d0 = 8; d0 < 12; ++d0) *reinterpret_cast<bf16x8*>(qpe + (d0 - 8) * 1024) = *reinterpret_cast<const bf16x8*>(Qw + d0 * 16);
  const int sr = tid >> 4, sc = (tid & 15) * 8, vst0 = v_st(sr, sc), vst1 = v_st(32 + sr, sc);
  int kgo[3], klo[3];
#pragma unroll
  for (int i = 0; i < 3; ++i) { const int idx = tid + 512 * i, row = idx / 24, g = idx % 24; kgo[i] = row * LDK + g * 8; klo[i] = KSWZ(row, g * 16); }
  const int vb0 = (int)(uintptr_t)V_lds + v_rd_base(lane);
  struct { bf16x8 vs0, vs1, ks0, ks1, ks2; } sr_[1];
#define SLOAD(i, k0) do { sr_[i].vs0 = *reinterpret_cast<const bf16x8*>(&Vh[(long)((k0) + sr) * LDV + sc]); sr_[i].vs1 = *reinterpret_cast<const bf16x8*>(&Vh[(long)((k0) + 32 + sr) * LDV + sc]); \
    sr_[i].ks0 = *reinterpret_cast<const bf16x8*>(&Kh[(long)(k0) * LDK + kgo[0]]); sr_[i].ks1 = *reinterpret_cast<const bf16x8*>(&Kh[(long)(k0) * LDK + kgo[1]]); \
    sr_[i].ks2 = *reinterpret_cast<const bf16x8*>(&Kh[(long)(k0) * LDK + kgo[2]]); } while (0)
#define SWRITE(b, i) do { *(bf16x8*)(V_lds + (b) * SHM_V + vst0) = sr_[i].vs0; *(bf16x8*)(V_lds + (b) * SHM_V + vst1) = sr_[i].vs1; \
    *(bf16x8*)(K_lds + (b) * SHM_K + klo[0]) = sr_[i].ks0; *(bf16x8*)(K_lds + (b) * SHM_K + klo[1]) = sr_[i].ks1; *(bf16x8*)(K_lds + (b) * SHM_K + klo[2]) = sr_[i].ks2; } while (0)
#define SWAIT() asm volatile("s_waitcnt vmcnt(0)" ::: "memory")
#define RESC(a) do { if (__any((a) < 1.f)) { if (hi == 0) al_l[r32] = (a); asm volatile("s_waitcnt lgkmcnt(0)" ::: "memory"); \
    _Pragma("unroll") for (int d = 0; d < 4; ++d) _Pragma("unroll") for (int r = 0; r < 16; ++r) o[d][r] *= al_l[crow(r, hi)]; } } while (0)
  f32x16 pA0, pA1, pB0, pB1; float mnA, mnB, alA, alB; bf16x8 pa0, pa1, pa2, pa3; const int NT = seq / KVBLK;
  int sc_ = 0, sn_ = 1, sp_ = 2;
#define ROT() do { sp_ = sc_; sc_ = sn_; sn_ = (sn_ == NRING - 1) ? 0 : sn_ + 1; } while (0)
  SLOAD(0, 0); asm volatile("s_waitcnt vmcnt(0)" ::: "memory"); SWRITE(0, 0); SLOAD(0, KVBLK); __syncthreads();
  qkt(pA0, pA1, K_lds, qr, qpe, r32, hi); partialSM(pA0, pA1, m_reg, mnA, alA);
  SWAIT(); SWRITE(1, 0); if (2 < NT) SLOAD(0, 2 * KVBLK); __syncthreads();
  ROT();
  for (int j = 1; j + 1 < NT; j += 2) {
    SBAR(); SWAIT(); SWRITE(sn_, 0); SLOAD(0, (j + 2) * KVBLK); SBAR();
    qkt(pB0, pB1, K_lds + sc_ * SHM_K, qr, qpe, r32, hi);
    finishSM(pA0, pA1, alA, l_reg, pa0, pa1, pa2, pa3); SBAR();
    pv_d0(o, vb0 + sp_ * SHM_V, pa0, pa1, pa2, pa3); partialSM(pB0, pB1, m_reg, mnB, alB); PV_SCHED(); SBAR();
    RESC(alB); __syncthreads(); ROT();
    SBAR(); SWAIT(); SWRITE(sn_, 0); if (j + 3 < NT) SLOAD(0, (j + 3) * KVBLK); SBAR();
    qkt(pA0, pA1, K_lds + sc_ * SHM_K, qr, qpe, r32, hi);
    finishSM(pB0, pB1, alB, l_reg, pa0, pa1, pa2, pa3); SBAR();
    pv_d0(o, vb0 + sp_ * SHM_V, pa0, pa1, pa2, pa3); partialSM(pA0, pA1, m_reg, mnA, alA); PV_SCHED(); SBAR();
    RESC(alA); __syncthreads(); ROT();
  }
  SBAR(); qkt(pB0, pB1, K_lds + sc_ * SHM_K, qr, qpe, r32, hi);
  finishSM(pA0, pA1, alA, l_reg, pa0, pa1, pa2, pa3); SBAR();
  pv_d0(o, vb0 + sp_ * SHM_V, pa0, pa1, pa2, pa3); partialSM(pB0, pB1, m_reg, mnB, alB);
  RESC(alB);
  finishSM(pB0, pB1, alB, l_reg, pa0, pa1, pa2, pa3); SBAR();
  pv_d0(o, vb0 + sc_ * SHM_V, pa0, pa1, pa2, pa3);
  __syncthreads();
#undef ROT
  if (hi == 0) li_l[r32] = l_reg; asm volatile("s_waitcnt lgkmcnt(0)" ::: "memory");
  bf16_t* stg = (bf16_t*)lds + wid * 4096;
#pragma unroll
  for (int r = 0; r < 16; ++r) { const int orow = crow(r, hi); const float rl = __builtin_amdgcn_rcpf(li_l[orow]);
#pragma unroll
    for (int d0 = 0; d0 < 4; ++d0) stg[orow * 128 + d0 * 32 + r32] = (bf16_t)(cvtpk(o[d0][r] * rl, 0.f) & 0xffffu); }
  asm volatile("s_waitcnt lgkmcnt(0)" ::: "memory");
  int le = threadIdx.x & 63; asm volatile("" : "+v"(le));
  bf16_t* Yw = Yb + (long)(wid * QBLK + (le >> 4)) * LDY + (le & 15) * 8; float* sq_l = ws + 64;
#pragma unroll
  for (int i = 0; i < 8; ++i) { const u32x4 v = *(const u32x4*)(stg + (i * 4 + (le >> 4)) * 128 + (le & 15) * 8); float s = 0.f;
#pragma unroll
    for (int e = 0; e < 4; ++e) { const float a = __uint_as_float(v[e] << 16), b = __uint_as_float(v[e] & 0xffff0000u); s += a * a + b * b; }
    s += __shfl_xor(s, 1); s += __shfl_xor(s, 2); s += __shfl_xor(s, 4); s += __shfl_xor(s, 8);
    if ((le & 15) == 0) sq_l[i * 4 + (le >> 4)] += s;
    *(u32x4*)(Yw + (long)(i * 4) * LDY) = v; }
  __syncthreads();
#undef SLOAD
#undef SWRITE
#undef SWAIT
#undef RESC
}
__device__ __forceinline__ void attn_unit(const bf16_t* Q, const bf16_t* KF, const bf16_t* VF, bf16_t* Y, const float* gb, int rowbase, int q0, int seq, char* lds) {
  int tid_ = threadIdx.x; asm volatile("" : "+v"(tid_));
  const int tid = tid_, wid = __builtin_amdgcn_readfirstlane(tid >> 6); int lane = tid & 63;
  float* sq_l = (float*)(lds + NRING * SHM_V + NRING * SHM_K) + wid * 96 + 64;
  if (lane < 32) sq_l[lane] = 0.f;
#pragma unroll 1
  for (int h = 0; h < 4; ++h)
    attn_head(Q + (long)(rowbase + q0) * LDQ + h * DQK, KF + (long)rowbase * LDK + h * DQK, VF + (long)rowbase * LDV + h * DV, Y + (long)(rowbase + q0) * LDY + 512 + h * DV, seq, lds);
  asm volatile("" : "+v"(lane));
  float ssq[8];
#pragma unroll
  for (int i = 0; i < 8; ++i) ssq[i] = __builtin_amdgcn_rsqf(sq_l[i * 4 + (lane >> 4)] * (1.0f / 512.0f) + 1e-6f);
  bf16_t* Yw = Y + (long)(rowbase + q0 + wid * QBLK + (lane >> 4)) * LDY + 512 + (lane & 15) * 8;
#pragma unroll 1
  for (int h = 0; h < 4; ++h) { const float* gp = gb + h * 128 + (lane & 15) * 8; const pg8::f32x4 g0 = *(const pg8::f32x4*)gp, g1 = *(const pg8::f32x4*)(gp + 4);
#pragma unroll
    for (int i = 0; i < 8; ++i) { bf16_t* p = Yw + (long)(i * 4) * LDY + h * 128; const u32x4 v = *(const u32x4*)p; const float rs = ssq[i]; u32x4 w;
      w.x = cvtpk(__uint_as_float(v.x << 16) * rs * g0[0], __uint_as_float(v.x & 0xffff0000u) * rs * g0[1]); w.y = cvtpk(__uint_as_float(v.y << 16) * rs * g0[2], __uint_as_float(v.y & 0xffff0000u) * rs * g0[3]);
      w.z = cvtpk(__uint_as_float(v.z << 16) * rs * g1[0], __uint_as_float(v.z & 0xffff0000u) * rs * g1[1]); w.w = cvtpk(__uint_as_float(v.w << 16) * rs * g1[2], __uint_as_float(v.w & 0xffff0000u) * rs * g1[3]);
      *(u32x4*)p = w; } }
}
#undef KSWZ
#undef SBAR
#undef PKV
}

namespace sgu {
using att::bf16x8; using att::s16x4; using att::f32x16; using att::bf16_t;
typedef unsigned u32x2 __attribute__((ext_vector_type(2)));
__device__ __forceinline__ float bf2f(unsigned short b) { return __uint_as_float((unsigned)b << 16); }
#define SG_PK(L, H) (bf16x8){L[0], L[1], L[2], L[3], H[0], H[1], H[2], H[3]}
template <int KS, int J> __device__ __forceinline__ void vread(int vbh, s16x4& l, s16x4& h) {
  l = att::tr_read<(KS >> 2) * 16384 + J * 512 + (KS & 3) * 4096>(vbh); h = att::tr_read<(KS >> 2) * 16384 + J * 512 + (KS & 3) * 4096 + 2048>(vbh);
}
__device__ __forceinline__ void sgu_unit(const bf16_t* __restrict__ Z, const bf16_t* __restrict__ Ws, const float* __restrict__ bsp, const float* __restrict__ gsgu, const float* __restrict__ ga,
                                         bf16_t* __restrict__ Y, int chunk, char* lds) {
  int tid_ = threadIdx.x; asm volatile("" : "+v"(tid_));
  const int tid = tid_, wid = __builtin_amdgcn_readfirstlane(tid >> 6), lane = tid & 63, r32 = lane & 31, hi = lane >> 5;
  const long row0 = (long)chunk * 128;
  {
    bf16x8 raw[16];
    const bf16_t* zp = Z + (row0 + wid) * 1792 + 512 + lane * 8;
#pragma unroll
    for (int i = 0; i < 16; ++i) raw[i] = *reinterpret_cast<const bf16x8*>(zp + (long)(8 * i) * 1792);
    const pg8::f32x4 g0 = *(const pg8::f32x4*)(gsgu + lane * 8), g1 = *(const pg8::f32x4*)(gsgu + lane * 8 + 4);
    char* ldst = lds + (lane >> 4) * 32768;
#pragma unroll
    for (int i = 0; i < 16; ++i) { const int row = wid + 8 * i;
      float f[8]; float ss = 0.f;
#pragma unroll
      for (int e = 0; e < 8; ++e) { f[e] = bf2f((unsigned short)raw[i][e]); ss += f[e] * f[e]; }
      ss += __shfl_xor(ss, 1); ss += __shfl_xor(ss, 2); ss += __shfl_xor(ss, 4); ss += __shfl_xor(ss, 8);
      const float rs = __builtin_amdgcn_rsqf(ss * (1.0f / 128.0f) + 1e-6f);
      pg8::f32x4 a = {f[0] * rs * g0[0], f[1] * rs * g0[1], f[2] * rs * g0[2], f[3] * rs * g0[3]}, b = {f[4] * rs * g1[0], f[5] * rs * g1[1], f[6] * rs * g1[2], f[7] * rs * g1[3]};
      *(pg8::u32x4*)(ldst + (row >> 6) * 16384 + att::v_st(row & 63, (lane & 15) * 8)) = pg8::pack8(a, b); }
  }
  __syncthreads();
  const int pb = wid >> 1, dsel = wid & 1;
  const int vb = (int)(uintptr_t)lds + att::v_rd_base(lane) + dsel * 1024;
  const long row = row0 + 32 * pb + r32;
  unsigned ypk[4][2][8]; float ssq = 0.f;
#pragma unroll
  for (int h = 0; h < 4; ++h) {
    u32x2 uu[2][4];
#pragma unroll
    for (int j = 0; j < 2; ++j)
#pragma unroll
      for (int rq = 0; rq < 4; ++rq) uu[j][rq] = *reinterpret_cast<const u32x2*>(Z + row * 1792 + h * 128 + 32 * (2 * dsel + j) + 8 * rq + 4 * hi);
    const float bb = bsp[h * 128 + 32 * pb + r32];
    const bf16_t* wp = Ws + (long)(h * 128 + 32 * pb + r32) * 128 + 8 * hi;
    bf16x8 wf[8];
#pragma unroll
    for (int ks = 0; ks < 8; ++ks) wf[ks] = *reinterpret_cast<const bf16x8*>(wp + 16 * ks);
    f32x16 acc0 = {}, acc1 = {};
    const int vbh = vb + h * 32768;
    { s16x4 l[8], hh[8];
      vread<0, 0>(vbh, l[0], hh[0]); vread<0, 1>(vbh, l[1], hh[1]); vread<1, 0>(vbh, l[2], hh[2]); vread<1, 1>(vbh, l[3], hh[3]);
      vread<2, 0>(vbh, l[4], hh[4]); vread<2, 1>(vbh, l[5], hh[5]); vread<3, 0>(vbh, l[6], hh[6]); vread<3, 1>(vbh, l[7], hh[7]);
      asm volatile("s_waitcnt lgkmcnt(0)" ::: "memory"); __builtin_amdgcn_sched_barrier(0);
#pragma unroll
      for (int ks = 0; ks < 4; ++ks) { acc0 = __builtin_amdgcn_mfma_f32_32x32x16_bf16(SG_PK(l[2 * ks], hh[2 * ks]), wf[ks], acc0, 0, 0, 0); acc1 = __builtin_amdgcn_mfma_f32_32x32x16_bf16(SG_PK(l[2 * ks + 1], hh[2 * ks + 1]), wf[ks], acc1, 0, 0, 0); } }
    { s16x4 l[8], hh[8];
      vread<4, 0>(vbh, l[0], hh[0]); vread<4, 1>(vbh, l[1], hh[1]); vread<5, 0>(vbh, l[2], hh[2]); vread<5, 1>(vbh, l[3], hh[3]);
      vread<6, 0>(vbh, l[4], hh[4]); vread<6, 1>(vbh, l[5], hh[5]); vread<7, 0>(vbh, l[6], hh[6]); vread<7, 1>(vbh, l[7], hh[7]);
      asm volatile("s_waitcnt lgkmcnt(0)" ::: "memory"); __builtin_amdgcn_sched_barrier(0);
#pragma unroll
      for (int ks = 0; ks < 4; ++ks) { acc0 = __builtin_amdgcn_mfma_f32_32x32x16_bf16(SG_PK(l[2 * ks], hh[2 * ks]), wf[4 + ks], acc0, 0, 0, 0); acc1 = __builtin_amdgcn_mfma_f32_32x32x16_bf16(SG_PK(l[2 * ks + 1], hh[2 * ks + 1]), wf[4 + ks], acc1, 0, 0, 0); } }
#pragma unroll
    for (int j = 0; j < 2; ++j)
#pragma unroll
      for (int rq = 0; rq < 4; ++rq) {
        const u32x2 u2 = uu[j][rq];
        const float u0 = __uint_as_float(u2.x << 16), u1 = __uint_as_float(u2.x & 0xffff0000u), u2f = __uint_as_float(u2.y << 16), u3 = __uint_as_float(u2.y & 0xffff0000u);
        const f32x16& ac = j ? acc1 : acc0;
        const float y0 = (ac[4 * rq + 0] + bb) * u0, y1 = (ac[4 * rq + 1] + bb) * u1, y2 = (ac[4 * rq + 2] + bb) * u2f, y3 = (ac[4 * rq + 3] + bb) * u3;
        ypk[h][j][2 * rq] = pg8::cvt_pk_bf16(y0, y1); ypk[h][j][2 * rq + 1] = pg8::cvt_pk_bf16(y2, y3);
        ssq += (y0 * y0 + y1 * y1) + (y2 * y2 + y3 * y3); }
  }
  ssq += __shfl_xor(ssq, 32);
  float* xs = (float*)(lds + 131072);
  if (hi == 0) xs[wid * 32 + r32] = ssq;
  __syncthreads();
  const float tot = xs[wid * 32 + r32] + xs[(wid ^ 1) * 32 + r32];
  const float rs = __builtin_amdgcn_rsqf(tot * (1.0f / 512.0f) + 1e-6f);
#pragma unroll
  for (int h = 0; h < 4; ++h)
#pragma unroll
    for (int j = 0; j < 2; ++j)
#pragma unroll
      for (int rq = 0; rq < 4; ++rq) { const int c = h * 128 + 32 * (2 * dsel + j) + 8 * rq + 4 * hi; const pg8::f32x4 gg = *(const pg8::f32x4*)(ga + c);
        const unsigned p0 = ypk[h][j][2 * rq], p1 = ypk[h][j][2 * rq + 1];
        u32x2 w; w.x = pg8::cvt_pk_bf16(__uint_as_float(p0 << 16) * rs * gg[0], __uint_as_float(p0 & 0xffff0000u) * rs * gg[1]); w.y = pg8::cvt_pk_bf16(__uint_as_float(p1 << 16) * rs * gg[2], __uint_as_float(p1 & 0xffff0000u) * rs * gg[3]);
        *reinterpret_cast<u32x2*>(Y + row * 1024 + c) = w; }
  __syncthreads();
}
#undef SG_PK
}

typedef unsigned short bf16;
typedef float f32x4 __attribute__((ext_vector_type(4)));
typedef unsigned v4u __attribute__((ext_vector_type(4)));
#define LAS __attribute__((address_space(3)))
constexpr int M_P = 8 * 4096, M_S = 32 * 2048, M = M_P + M_S;
constexpr int DM = 1024, NZ = 1792, FF = 4096;
constexpr size_t MiB = 1u << 20;
constexpr size_t WS_WIN = 1 * MiB, WS_WUQ = 5 * MiB, WS_WUKV = 6 * MiB, WS_WOUT = 7 * MiB, WS_W1 = 9 * MiB, WS_W2 = 17 * MiB, WS_WS = 25 * MiB, WS_ROPEC = 26 * MiB, WS_ROPES = 27 * MiB;
constexpr size_t WS_ST1 = 28 * MiB, WS_ST2 = 36 * MiB;
constexpr size_t WS_XN = 48 * MiB;
constexpr size_t WS_Z = 240 * MiB, WS_KF = 576 * MiB, WS_VF = 720 * MiB, WS_Y = 816 * MiB;
constexpr size_t WS_F = 240 * MiB, WS_END = 1008 * MiB;
constexpr int LDS_BYTES = att::SHM_ATTN + 32768;
constexpr int NWAVES = 8;
constexpr int LDS_CTL_OFF = LDS_BYTES, LDS_TOTAL = LDS_BYTES + 64;
constexpr size_t WS_BAR = 0, WS_CNT = 16384, BAR_ZERO_BYTES = 16384 + 384 * 256;

__device__ __forceinline__ unsigned f2bf(float f) { unsigned u = __builtin_bit_cast(unsigned, f); return (u + 0x7fffu + ((u >> 16) & 1u)) >> 16; }
__device__ __forceinline__ unsigned pk2(float lo, float hi) { return f2bf(lo) | (f2bf(hi) << 16); }
__device__ __forceinline__ float wave_sum(float v) {
#pragma unroll
    for (int o = 1; o < 64; o <<= 1) v += __shfl_xor(v, o);
    return v;
}
__device__ __forceinline__ int colmap(int mode, int nd) {
    if (mode == 1) { if (nd < 1664) return nd; if (nd < 1728) { const int j = nd - 1664; return 1664 + (j & 1) * 32 + (j >> 1); } return -1; }
    if (mode == 2) { const int h = nd / 192, d = nd % 192; if (d < 128) return nd; const int j = d - 128; return h * 192 + 128 + (j & 1) * 32 + (j >> 1); }
    if (mode == 3) { const int t = nd >> 9, hh = (nd >> 7) & 3, d = nd & 127; return hh * 256 + t * 128 + d; }
    return nd;
}
__device__ __forceinline__ void transpose_item(const float* W, int K, int N, int Npad, bf16* WT, const float* gain, int mode, LAS float* scr, int item, int lane) {
    const int nblk = Npad / 32, kb = item / nblk, nb = item % nblk, k0 = 64 * kb, n0 = 32 * nb;
    const int src = colmap(mode, n0 + (lane & 31));
#pragma unroll 8
    for (int i = 0; i < 32; ++i) { const int kk = 2 * i + (lane >> 5); float v = 0.f; if (src >= 0) { v = W[(size_t)(k0 + kk) * N + src]; if (gain) v *= gain[k0 + kk]; } scr[kk * 33 + (lane & 31)] = v; }
    asm volatile("s_waitcnt lgkmcnt(0)" ::: "memory");
    const int c = lane & 7;
#pragma unroll
    for (int j = 0; j < 4; ++j) { const int n = (lane >> 3) + 8 * j; const LAS float* s = scr + (8 * c) * 33 + n;
        v4u o; o.x = pk2(s[0 * 33], s[1 * 33]); o.y = pk2(s[2 * 33], s[3 * 33]); o.z = pk2(s[4 * 33], s[5 * 33]); o.w = pk2(s[6 * 33], s[7 * 33]);
        *(v4u*)(WT + (size_t)(n0 + n) * K + k0 + 8 * c) = o; }
    asm volatile("s_waitcnt lgkmcnt(0)" ::: "memory");
}
typedef __attribute__((address_space(1))) unsigned gu32;
#define XB_TMO      128
#define XB_XCNT(j)  (256  + 64 * (j))
#define XB_XSUB(j)  (1280 + 64 * (j))
#define XB_XGEN(j)  (2304 + 64 * (j))
#define XB_TOP      3328
#define XB_TOPGEN   3392
#define XCD_BAR_WORDS 3456
#define XB_SPIN_CAP (1u << 18)

__device__ __forceinline__ unsigned xb_ld(unsigned* p)              { return __hip_atomic_load(p, __ATOMIC_RELAXED, __HIP_MEMORY_SCOPE_AGENT); }
__device__ __forceinline__ unsigned xb_add(unsigned* p, unsigned v) { return __hip_atomic_fetch_add(p, v, __ATOMIC_RELAXED, __HIP_MEMORY_SCOPE_AGENT); }
__device__ __forceinline__ unsigned xb_xcc_id() { return (unsigned)__builtin_amdgcn_s_getreg((3 << 11) | 20) & 0xFu; }
#define XB_SPIN(cond, bar) do { unsigned _sp = 0; while (cond) { __builtin_amdgcn_s_sleep(1); \
    if ((++_sp & 255u) == 0u) { if (xb_ld(&(bar)[XB_TMO])) break; if (_sp > XB_SPIN_CAP) { atomicAdd(&(bar)[XB_TMO], 1u); break; } } } } while (0)

struct XcdBarrier {
    unsigned* bar; unsigned x;
    volatile LAS unsigned* st;
};

__device__ __forceinline__ XcdBarrier xcd_barrier_post(unsigned* bar, volatile LAS unsigned* st) {
    XcdBarrier b; b.bar = bar; b.x = xb_xcc_id(); b.st = st;
    if (threadIdx.x == 0) (void)xb_add(&bar[XB_XCNT(b.x)], 1u);
    return b;
}
__device__ __forceinline__ void xcd_barrier_complete(unsigned* bar, unsigned x, unsigned& nloc, unsigned& nx) {
    const unsigned G = gridDim.x * gridDim.y * gridDim.z;
    unsigned sum, cnt, mine, sp = 0u;
    for (;;) {
        sum = 0u; cnt = 0u; mine = 0u;
#pragma unroll
        for (unsigned j = 0; j < 16; ++j) { const unsigned c = xb_ld(&bar[XB_XCNT(j)]); sum += c; cnt += (c > 0u) ? 1u : 0u; mine = (j == x) ? c : mine; }
        if (sum == G) break;
        __builtin_amdgcn_s_sleep(1);
        if ((++sp & 255u) == 0u) { if (xb_ld(&bar[XB_TMO])) break; if (sp > XB_SPIN_CAP) { atomicAdd(&bar[XB_TMO], 1u); break; } }
    }
    nloc = mine > 0u ? mine : 1u; nx = cnt > 0u ? cnt : 1u;
}

__device__ __forceinline__ void xcd_barrier(const XcdBarrier& b) {
    asm volatile("s_waitcnt vmcnt(0)" ::: "memory");
    __syncthreads();
    if (threadIdx.x == 0) {
        unsigned* bar = b.bar;
        __builtin_amdgcn_s_waitcnt(0);
        unsigned nloc = b.st[0], nx = b.st[1];
        if (nloc == 0u) { xcd_barrier_complete(bar, b.x, nloc, nx); b.st[0] = nloc; b.st[1] = nx; }
        const unsigned old = xb_add(&bar[XB_XSUB(b.x)], 1u);
        const unsigned gen = old / nloc;
        if (old + 1u == (gen + 1u) * nloc) {
            __builtin_amdgcn_fence(__ATOMIC_RELEASE, "agent");
            asm volatile("s_waitcnt vmcnt(0)" ::: "memory");
            const unsigned og = xb_add(&bar[XB_TOP], 1u);
            const unsigned tg = og / nx;
            if (og + 1u == (tg + 1u) * nx) xb_add(&bar[XB_TOPGEN], 1u);
            else XB_SPIN(xb_ld(&bar[XB_TOPGEN]) == tg, bar);
            __builtin_amdgcn_fence(__ATOMIC_ACQUIRE, "agent");
            xb_add(&bar[XB_XGEN(b.x)], 1u);
            asm volatile("s_waitcnt vmcnt(0)" ::: "memory");
        } else {
            XB_SPIN(xb_ld(&bar[XB_XGEN(b.x)]) == gen, bar);
            __builtin_amdgcn_fence(__ATOMIC_ACQUIRE, "agent");
            asm volatile("s_waitcnt vmcnt(0)" ::: "memory");
        }
    }
    __syncthreads();
}

struct Params { const float* in[18]; float* out; unsigned char* ws; int ph_lo, ph_hi; };
enum { I_XP = 0, I_XS, I_NMIX, I_WIN, I_SGUN, I_WSP, I_BSP, I_QN, I_WUQ, I_KVN, I_WUKV, I_ONA, I_ONB, I_WOUT, I_NFFN, I_W1, I_W2, I_NFIN };

__global__ void __launch_bounds__(NWAVES * 64, 2) mega_fwd(Params p) {
    extern __shared__ __attribute__((aligned(16))) unsigned char lds[];
    namespace cg = cooperative_groups;
    const int tid = threadIdx.x, lane = tid & 63, wave = __builtin_amdgcn_readfirstlane(tid >> 6);
    const int G = gridDim.x, bx = blockIdx.x;
    const int vcu = (G % 8 == 0) ? (bx % 8) * (G / 8) + bx / 8 : bx;
    unsigned char* ws = p.ws;
    bf16* Win_t = (bf16*)(ws + WS_WIN); bf16* Wuq_t = (bf16*)(ws + WS_WUQ); bf16* Wukv_t = (bf16*)(ws + WS_WUKV); bf16* Wout_t = (bf16*)(ws + WS_WOUT);
    bf16* W1_t = (bf16*)(ws + WS_W1); bf16* W2_t = (bf16*)(ws + WS_W2); bf16* Wsb = (bf16*)(ws + WS_WS);
    float* ropec = (float*)(ws + WS_ROPEC); float* ropes = (float*)(ws + WS_ROPES); float* stat1 = (float*)(ws + WS_ST1); float* stat2 = (float*)(ws + WS_ST2);
    bf16* XN = (bf16*)(ws + WS_XN); bf16* Qb = XN; bf16* XB = XN;
    bf16* Z = (bf16*)(ws + WS_Z); bf16* KF = (bf16*)(ws + WS_KF); bf16* VF = (bf16*)(ws + WS_VF); bf16* Y = (bf16*)(ws + WS_Y); bf16* Fb = (bf16*)(ws + WS_F);
    const int lo = p.ph_lo, hi_ = p.ph_hi;
    volatile LAS unsigned* bst = (volatile LAS unsigned*)((LAS unsigned char*)lds + LDS_CTL_OFF);
    if (tid < 16) bst[tid] = 0u;
    __syncthreads();
    XcdBarrier bar; bar.bar = (unsigned*)(ws + WS_BAR); bar.x = 0; bar.st = bst;
    if (hi_ - lo > 1) bar = xcd_barrier_post((unsigned*)(ws + WS_BAR), bst);
#ifndef PHMASK
#define PHMASK 0xFF
#endif
#ifndef REPMASK
#define REPMASK 0
#endif
#define REPS(k) for (int rep_ = 0; rep_ < (((REPMASK) >> (k)) & 1) + 1; ++rep_)
#define IN(k) ((((PHMASK) >> (k)) & 1) && lo <= (k) && (k) < hi_)
#define SEAM(k) do { if (IN(k) && IN((k) + 1)) { xcd_barrier(bar); } } while (0)
    const int gw = vcu * NWAVES + wave, NGW = G * NWAVES;
    if (lo < 0) cg::this_grid().sync();

    if (IN(0)) REPS(0) {
        LAS float* scr = (LAS float*)((LAS unsigned char*)lds + wave * 16384);
        constexpr int I_A = 16 * 56, I_B = 6 * 24, I_C = 4 * 32, I_D = 16 * 32, I_E = 16 * 128, I_F = 64 * 32;
        for (int it = gw; it < I_A + I_B + I_C + I_D + I_E + I_F; it += NGW) {
            int r = it;
            if (r < I_A) { transpose_item(p.in[I_WIN], 1024, 1728, 1792, Win_t, p.in[I_NMIX], 1, scr, r, lane); continue; } r -= I_A;
            if (r < I_B) { transpose_item(p.in[I_WUQ], 384, 768, 768, Wuq_t, p.in[I_QN], 2, scr, r, lane); continue; } r -= I_B;
            if (r < I_C) { transpose_item(p.in[I_WUKV], 256, 1024, 1024, Wukv_t, p.in[I_KVN], 3, scr, r, lane); continue; } r -= I_C;
            if (r < I_D) { transpose_item(p.in[I_WOUT], 1024, 1024, 1024, Wout_t, nullptr, 0, scr, r, lane); continue; } r -= I_D;
            if (r < I_E) { transpose_item(p.in[I_W1], 1024, 4096, 4096, W1_t, p.in[I_NFFN], 0, scr, r, lane); continue; } r -= I_E;
            transpose_item(p.in[I_W2], 4096, 1024, 1024, W2_t, nullptr, 0, scr, r, lane);
        }
        for (int i = bx * 512 + tid; i < 4 * 128 * 128 / 2; i += G * 512) { const float a = p.in[I_WSP][2 * i], b = p.in[I_WSP][2 * i + 1]; ((unsigned*)Wsb)[i] = pk2(a, b); }
        for (int i = bx * 512 + tid; i < 4096 * 32; i += G * 512) { const int pos = i >> 5, k = i & 31;
            const float inv = __builtin_amdgcn_exp2f(-(float)k * 0.41524101186092029f); const float ang = (float)pos * inv;
            const double t = (double)ang * 0.15915494309189535; const float fr = (float)(t - __builtin_floor(t));
            ropec[i] = __builtin_amdgcn_cosf(fr); ropes[i] = __builtin_amdgcn_sinf(fr); }
        for (int m = gw; m < M; m += 2 * NGW) {
            const int m2 = m + NGW;
            const float* xrow = (m < M_P) ? p.in[I_XP] + (size_t)m * DM : p.in[I_XS] + (size_t)(m - M_P) * DM;
            const float* xrow2 = (m2 < M_P) ? p.in[I_XP] + (size_t)m2 * DM : p.in[I_XS] + (size_t)(m2 - M_P) * DM;
            const f32x4* xr = (const f32x4*)xrow + lane; const f32x4* xr2 = (const f32x4*)xrow2 + lane; f32x4 v[4], w[4]; float s = 0.f, s2 = 0.f;
#pragma unroll
            for (int j = 0; j < 4; ++j) { v[j] = xr[64 * j]; w[j] = xr2[64 * j]; }
#pragma unroll
            for (int j = 0; j < 4; ++j) { s += (v[j].x * v[j].x + v[j].y * v[j].y) + (v[j].z * v[j].z + v[j].w * v[j].w); s2 += (w[j].x * w[j].x + w[j].y * w[j].y) + (w[j].z * w[j].z + w[j].w * w[j].w); }
            const float rstd = __builtin_amdgcn_rsqf(wave_sum(s) * (1.f / DM) + 1e-6f), rstd2 = __builtin_amdgcn_rsqf(wave_sum(s2) * (1.f / DM) + 1e-6f);
            unsigned long long* o8 = (unsigned long long*)(XN + (size_t)m * DM) + lane; unsigned long long* o82 = (unsigned long long*)(XN + (size_t)m2 * DM) + lane;
#pragma unroll
            for (int j = 0; j < 4; ++j) { o8[64 * j] = (unsigned long long)pk2(v[j].x * rstd, v[j].y * rstd) | ((unsigned long long)pk2(v[j].z * rstd, v[j].w * rstd) << 32);
                                          o82[64 * j] = (unsigned long long)pk2(w[j].x * rstd2, w[j].y * rstd2) | ((unsigned long long)pk2(w[j].z * rstd2, w[j].w * rstd2) << 32); }
        }
    }
    SEAM(0);
    if (IN(1)) REPS(1) {
        pg8::Gemm g{XN, Win_t, M, NZ, DM, DM, DM}; pg8::StaticOrder S; S.init(M, NZ, G, bx);
        pg8::EpiZ E{Z, KF, stat1, ropec, ropes};
        pg8::gemm_phase<pg8::EpiZ, pg8::StaticOrder, true, true>((LAS unsigned char*)lds, g, S, E);
    }
    SEAM(1);
#ifndef REP2
#define REP2 1
#endif
    if (IN(2)) for (int rep_ = 0; rep_ < REP2; ++rep_) {
#ifndef NO_GQ
        { pg8::Gemm g{Z + 1024, Wuq_t, M, 768, 384, NZ, 384}; pg8::StaticOrder S; S.init(M, 768, G, bx);
          pg8::EpiQ E{Qb, stat1, ropec, ropes};
          pg8::gemm_phase<pg8::EpiQ, pg8::StaticOrder, true, true>((LAS unsigned char*)lds, g, S, E); }
#endif
#ifndef NO_GKV
        { pg8::Gemm g{Z + 1408, Wukv_t, M, 1024, 256, NZ, 256}; pg8::StaticOrder S; S.init(M, 1024, G, bx);
          pg8::EpiKV E{KF, VF, stat1};
          pg8::gemm_phase<pg8::EpiKV, pg8::StaticOrder, true, true>((LAS unsigned char*)lds, g, S, E); }
#endif
        __syncthreads();
#ifndef NO_SGU
#ifndef REP2S
#define REP2S 1
#endif
        for (int rs_ = 0; rs_ < REP2S; ++rs_)
        for (int c = vcu; c < M / 128; c += G) sgu::sgu_unit(Z, Wsb, p.in[I_BSP], p.in[I_SGUN], p.in[I_ONA], Y, c, (char*)lds);
#endif
    }
    SEAM(2);
#ifndef REP3
#define REP3 1
#endif
    if (IN(3)) for (int rep_ = 0; rep_ < REP3; ++rep_) {
        for (int it = 0;; ++it) {
            int u;
            if (G == 256) { if (vcu < 128) { if (it > 0) break; u = vcu; } else { if (it > 1) break; u = 128 + 2 * (vcu - 128) + it; } }
            else { u = bx + it * G; if (u >= 384) break; }
            const int s_ = u - 128;
            const int rowbase = (u < 128) ? (u >> 4) * 4096 : M_P + (s_ >> 3) * 2048, q0 = (u < 128) ? (u & 15) * 256 : (s_ & 7) * 256, seq = (u < 128) ? 4096 : 2048;
            att::attn_unit(Qb, KF, VF, Y, p.in[I_ONB], rowbase, q0, seq, (char*)lds);
        }
    }
    SEAM(3);
    if (IN(4)) REPS(4) {
        pg8::Gemm g{Y, Wout_t, M, DM, DM, DM, DM}; pg8::StaticOrder S; S.init(M, DM, G, bx);
        pg8::EpiX1 E{p.in[I_XP], p.in[I_XS], p.out, XB, stat2};
        pg8::gemm_phase<pg8::EpiX1, pg8::StaticOrder, true, true>((LAS unsigned char*)lds, g, S, E);
    }
    SEAM(4);
    if (IN(5)) REPS(5) {
        pg8::Gemm g{XB, W1_t, M, FF, DM, DM, DM}; pg8::StaticOrder S; S.init(M, FF, G, bx);
        pg8::EpiF E{Fb, stat2};
        pg8::gemm_phase<pg8::EpiF, pg8::StaticOrder, true, true>((LAS unsigned char*)lds, g, S, E);
    }
    SEAM(5);
    if (IN(6)) REPS(6) {
        pg8::Gemm g{Fb, W2_t, M, DM, FF, FF, FF}; pg8::StaticOrder S; S.init(M, DM, G, bx);
        pg8::EpiX2 E{p.out, XB};
        pg8::gemm_phase<pg8::EpiX2, pg8::StaticOrder, true, true>((LAS unsigned char*)lds, g, S, E);
    }
    SEAM(6);
    if (IN(7)) {
        int t7 = threadIdx.x; asm volatile("" : "+v"(t7)); const int ln = t7 & 63;
        const f32x4* gf = (const f32x4*)p.in[I_NFIN] + ln; f32x4 gv[4];
#pragma unroll
        for (int j = 0; j < 4; ++j) gv[j] = gf[64 * j];
        for (int m = vcu * NWAVES + (t7 >> 6); m < M; m += 2 * NGW) {
            f32x4* xr = (f32x4*)(p.out + (size_t)m * DM) + ln; f32x4* xr2 = (f32x4*)(p.out + (size_t)(m + NGW) * DM) + ln; f32x4 v[4], w[4]; float s = 0.f, s2 = 0.f;
#pragma unroll
            for (int j = 0; j < 4; ++j) { v[j] = xr[64 * j]; w[j] = xr2[64 * j]; }
#pragma unroll
            for (int j = 0; j < 4; ++j) { s += (v[j].x * v[j].x + v[j].y * v[j].y) + (v[j].z * v[j].z + v[j].w * v[j].w); s2 += (w[j].x * w[j].x + w[j].y * w[j].y) + (w[j].z * w[j].z + w[j].w * w[j].w); }
            const float rstd = __builtin_amdgcn_rsqf(wave_sum(s) * (1.f / DM) + 1e-6f), rstd2 = __builtin_amdgcn_rsqf(wave_sum(s2) * (1.f / DM) + 1e-6f);
#pragma unroll
            for (int j = 0; j < 4; ++j) { xr[64 * j] = v[j] * rstd * gv[j]; xr2[64 * j] = w[j] * rstd2 * gv[j]; }
        }
    }
#undef IN
#undef SEAM
}

#ifndef MK_N_LAUNCHES
#define MK_N_LAUNCHES 1
#endif
extern "C" void kernel_launch(void* const* d_in, const int* in_sizes, int n_in, void* d_out, int out_size, void* d_ws, size_t ws_size, hipStream_t stream) {
    static int grid = 0;
    if (grid == 0) {
        if (n_in != 18 || in_sizes[0] != M_P * DM || in_sizes[1] != M_S * DM || out_size != M * DM || ws_size < WS_END) {
            fprintf(stderr, "kernel_launch: unexpected shapes (n_in %d, in0 %d, in1 %d, out %d, ws %zu); nothing launched\n", n_in, n_in > 0 ? in_sizes[0] : -1, n_in > 1 ? in_sizes[1] : -1, out_size, ws_size); grid = -1; return; }
        int dev = 0, cus = 0, per_cu = 0;
        if (hipGetDevice(&dev) != hipSuccess || hipDeviceGetAttribute(&cus, hipDeviceAttributeMultiprocessorCount, dev) != hipSuccess) { grid = -1; return; }
        if (hipFuncSetAttribute((const void*)mega_fwd, hipFuncAttributeMaxDynamicSharedMemorySize, LDS_TOTAL) != hipSuccess) { fprintf(stderr, "kernel_launch: hipFuncSetAttribute failed\n"); grid = -1; return; }
        if (hipOccupancyMaxActiveBlocksPerMultiprocessor(&per_cu, (const void*)mega_fwd, NWAVES * 64, LDS_TOTAL) != hipSuccess || per_cu < 1) { fprintf(stderr, "kernel_launch: occupancy query says %d\n", per_cu); per_cu = 1; }
        (void)hipGetLastError();
        grid = cus * per_cu;
    }
    if (grid < 0) return;
    if (hipMemsetAsync((char*)d_ws + WS_BAR, 0, BAR_ZERO_BYTES, stream) != hipSuccess) { fprintf(stderr, "kernel_launch: memset failed\n"); return; }
    Params a{};
    for (int i = 0; i < 18; ++i) a.in[i] = (const float*)d_in[i];
    a.out = (float*)d_out; a.ws = (unsigned char*)d_ws;
    if (MK_N_LAUNCHES == 1) {
        a.ph_lo = 0; a.ph_hi = 8;
        void* args[] = {&a};
        const hipError_t e = hipLaunchCooperativeKernel((const void*)mega_fwd, dim3(grid), dim3(NWAVES * 64), args, LDS_TOTAL, stream);
        if (e != hipSuccess) fprintf(stderr, "kernel_launch: cooperative launch failed: %s (grid %d)\n", hipGetErrorString(e), grid);
    } else {
        for (int ph = 0; ph < 8; ++ph) { a.ph_lo = ph; a.ph_hi = ph + 1; hipLaunchKernelGGL(mega_fwd, dim3(grid), dim3(NWAVES * 64), LDS_TOTAL, stream, a); }
    }
}
```
